# Optimizing an MI355X kernel written in HIP

```python
import numpy as np
import jax, jax.numpy as jnp
from jax import lax

D_MODEL = 2048
BATCH = 2
SEQ = 4096
DEPTH = 1
DEC_BATCH = 8
DEC_SEQ = 2048
PAST_LEN = 128

HEAD_DIM = 128
N_HEADS_A = 8
N_KV_HEADS_A = 2
N_HEADS_B = 8
GRID_W = 64
WIN_ROWS_MAX = 8
WIN_COLS = 16
COL_SEG = 16
KEY_COLS = 32
Q_BLOCK = 128
D_FF = 5504
ROPE_THETA = 10000.0
EPS = 1e-6
RPB_STD = 0.02

WIDTH_QA = N_HEADS_A * HEAD_DIM
WIDTH_KVA = N_KV_HEADS_A * HEAD_DIM
WIDTH_B = N_HEADS_B * HEAD_DIM
IN_SPLITS = (WIDTH_QA, WIDTH_KVA, WIDTH_KVA, WIDTH_B, WIDTH_B, WIDTH_B, D_MODEL, D_MODEL)
IN_WIDTH = sum(IN_SPLITS)
IN_OFFSETS = tuple(int(o) for o in np.cumsum(IN_SPLITS)[:-1])

kernel_name = "hybrid_gqa_natten_macaron_encoder"


def rms_norm(x, g):
    xf = x.astype(jnp.float32)
    y = xf * lax.rsqrt(jnp.mean(xf * xf, axis=-1, keepdims=True) + EPS)
    return (y * g.astype(jnp.float32)).astype(x.dtype)


def swiglu(x, w_in, w_out):
    gate, up = jnp.split(x @ w_in, 2, axis=-1)
    return (jax.nn.silu(gate) * up) @ w_out


def axial_rope_tables(T):
    t = np.arange(T)
    row = (t // GRID_W).astype(np.float32)
    col = (t % GRID_W).astype(np.float32)
    n_pairs_axis = HEAD_DIM // 4
    inv = (ROPE_THETA ** (-np.arange(n_pairs_axis, dtype=np.float32) / n_pairs_axis)).astype(np.float32)
    ang = np.concatenate([row[:, None] * inv[None], col[:, None] * inv[None]], axis=-1)
    return jnp.asarray(np.cos(ang), jnp.float32), jnp.asarray(np.sin(ang), jnp.float32)


def apply_rope(x, cos, sin):
    xf = x.astype(jnp.float32).reshape(x.shape[:-1] + (HEAD_DIM // 2, 2))
    x0, x1 = xf[..., 0], xf[..., 1]
    c, s = cos[:, None, :], sin[:, None, :]
    out = jnp.stack([x0 * c - x1 * s, x0 * s + x1 * c], axis=-1)
    return out.reshape(x.shape).astype(x.dtype)


def global_gqa(q, k, v, g_q, g_k):
    B, T = q.shape[0], q.shape[1]
    cos, sin = axial_rope_tables(T)
    q = apply_rope(rms_norm(q, g_q), cos, sin)
    k = apply_rope(rms_norm(k, g_k), cos, sin)
    G = N_HEADS_A // N_KV_HEADS_A
    nb = T // Q_BLOCK
    qb = q.reshape(B, nb, Q_BLOCK, N_KV_HEADS_A, G, HEAD_DIM).transpose(1, 0, 2, 3, 4, 5)
    scale = HEAD_DIM ** -0.5

    def block(qi):
        s = jnp.einsum('bqkgd,bskd->bkgqs', qi, k, preferred_element_type=jnp.float32) * scale
        p = jax.nn.softmax(s, axis=-1).astype(v.dtype)
        return jnp.einsum('bkgqs,bskd->bqkgd', p, v)

    o = lax.map(block, qb)
    return o.transpose(1, 0, 2, 3, 4, 5).reshape(B, T, WIDTH_QA)


def neighbourhood_attn(q, k, v, rpb):
    B, T, H, hd = q.shape
    rows = T // GRID_W
    wr = min(WIN_ROWS_MAX, rows)
    n_seg = GRID_W // COL_SEG
    qc = np.arange(GRID_W).reshape(n_seg, COL_SEG)
    seg_start = np.clip(qc[:, 0] - WIN_COLS // 2, 0, GRID_W - KEY_COLS)
    kc = seg_start[:, None] + np.arange(KEY_COLS)[None, :]
    cs = np.clip(qc - WIN_COLS // 2, 0, GRID_W - WIN_COLS)
    valid = (kc[:, None, :] >= cs[:, :, None]) & (kc[:, None, :] < cs[:, :, None] + WIN_COLS)
    dc_idx = np.clip(kc[:, None, :] - qc[:, :, None] + WIN_COLS - 1, 0, 2 * WIN_COLS - 2)
    mask_add = jnp.asarray(np.where(valid, 0.0, -1e30).astype(np.float32))[:, :, None, :]
    qg = q.reshape(B, rows, n_seg, COL_SEG, H, hd)
    kg = k.reshape(B, rows, GRID_W, H, hd)
    vg = v.reshape(B, rows, GRID_W, H, hd)
    scale = hd ** -0.5
    rpb_f = rpb.astype(jnp.float32)

    def row_block(r):
        rs = jnp.clip(r - wr // 2, 0, rows - wr)
        kb = lax.dynamic_slice_in_dim(kg, rs, wr, axis=1)[:, :, kc]
        vb = lax.dynamic_slice_in_dim(vg, rs, wr, axis=1)[:, :, kc]
        qr = lax.dynamic_index_in_dim(qg, r, axis=1, keepdims=False)
        s = jnp.einsum('bnqhd,bwnkhd->bhnqwk', qr, kb, preferred_element_type=jnp.float32) * scale
        dr_idx = rs + jnp.arange(wr) - r + WIN_ROWS_MAX - 1
        bias = jnp.take(rpb_f, dr_idx, axis=1)[:, :, dc_idx]
        s = s + bias.transpose(0, 2, 3, 1, 4) + mask_add
        p = jax.nn.softmax(s.reshape(s.shape[:4] + (wr * KEY_COLS,)), axis=-1).reshape(s.shape)
        o = jnp.einsum('bhnqwk,bwnkhd->bnqhd', p.astype(vb.dtype), vb)
        return o.reshape(B, GRID_W, H * hd)

    o = lax.map(row_block, jnp.arange(rows))
    return o.transpose(1, 0, 2, 3).reshape(B, T, H * hd)


def encoder_layer(x, g_ffn1, w_ffn1_in, w_ffn1_out, g_mix, w_in, b_gate, g_q_a, g_k_a, rpb_b,
                  w_branch_a, w_branch_b, w_out, g_ffn2, w_ffn2_in, w_ffn2_out):
    B, T, _ = x.shape
    h = x + 0.5 * swiglu(rms_norm(x, g_ffn1), w_ffn1_in, w_ffn1_out)
    u = rms_norm(h, g_mix)
    qa, ka, va, qb, kb, vb, gate_a, gate_b = jnp.split(u @ w_in, IN_OFFSETS, axis=-1)
    ya = global_gqa(qa.reshape(B, T, N_HEADS_A, HEAD_DIM), ka.reshape(B, T, N_KV_HEADS_A, HEAD_DIM),
                    va.reshape(B, T, N_KV_HEADS_A, HEAD_DIM), g_q_a, g_k_a)
    yb = neighbourhood_attn(qb.reshape(B, T, N_HEADS_B, HEAD_DIM), kb.reshape(B, T, N_HEADS_B, HEAD_DIM),
                            vb.reshape(B, T, N_HEADS_B, HEAD_DIM), rpb_b)
    ga, gb = jnp.split(b_gate, 2)
    merged = jax.nn.sigmoid(gate_a + ga) * (ya @ w_branch_a) + jax.nn.sigmoid(gate_b + gb) * (yb @ w_branch_b)
    h = h + merged @ w_out
    h = h + 0.5 * swiglu(rms_norm(h, g_ffn2), w_ffn2_in, w_ffn2_out)
    return h


def setup_inputs(seed: int = 0) -> dict:
    key = jax.random.key(seed)
    ks = jax.random.split(key, 20)
    f32 = jnp.float32

    def w(k, shape, fan_in):
        return jax.random.normal(k, shape, f32) * (fan_in ** -0.5)

    def gain(k, shape):
        return 1.0 + 0.02 * jax.random.normal(k, shape, f32)

    return {
        "x_prompt": jax.random.normal(ks[0], (BATCH, SEQ, D_MODEL), f32),
        "x_sample": jax.random.normal(ks[1], (DEC_BATCH, DEC_SEQ, D_MODEL), f32),
        "g_ffn1": gain(ks[2], (DEPTH, D_MODEL)),
        "w_ffn1_in": w(ks[3], (DEPTH, D_MODEL, 2 * D_FF), D_MODEL),
        "w_ffn1_out": w(ks[4], (DEPTH, D_FF, D_MODEL), D_FF),
        "g_mix": gain(ks[5], (DEPTH, D_MODEL)),
        "w_in": w(ks[6], (DEPTH, D_MODEL, IN_WIDTH), D_MODEL),
        "b_gate": 0.02 * jax.random.normal(ks[7], (DEPTH, 2 * D_MODEL), f32),
        "g_q_a": gain(ks[8], (DEPTH, HEAD_DIM)),
        "g_k_a": gain(ks[9], (DEPTH, HEAD_DIM)),
        "rpb_b": RPB_STD * jax.random.normal(ks[10], (DEPTH, N_HEADS_B, 2 * WIN_ROWS_MAX - 1, 2 * WIN_COLS - 1), f32),
        "w_branch_a": w(ks[11], (DEPTH, WIDTH_QA, D_MODEL), WIDTH_QA),
        "w_branch_b": w(ks[12], (DEPTH, WIDTH_B, D_MODEL), WIDTH_B),
        "w_out": w(ks[13], (DEPTH, D_MODEL, D_MODEL), D_MODEL),
        "g_ffn2": gain(ks[14], (DEPTH, D_MODEL)),
        "w_ffn2_in": w(ks[15], (DEPTH, D_MODEL, 2 * D_FF), D_MODEL),
        "w_ffn2_out": w(ks[16], (DEPTH, D_FF, D_MODEL), D_FF),
        "g_final": gain(ks[17], (D_MODEL,)),
    }


def reference(x_prompt, x_sample, g_ffn1, w_ffn1_in, w_ffn1_out, g_mix, w_in, b_gate, g_q_a, g_k_a,
              rpb_b, w_branch_a, w_branch_b, w_out, g_ffn2, w_ffn2_in, w_ffn2_out, g_final):
    def trunk(x):
        h = x
        for l in range(DEPTH):
            h = encoder_layer(h, g_ffn1[l], w_ffn1_in[l], w_ffn1_out[l], g_mix[l], w_in[l], b_gate[l],
                              g_q_a[l], g_k_a[l], rpb_b[l], w_branch_a[l], w_branch_b[l], w_out[l],
                              g_ffn2[l], w_ffn2_in[l], w_ffn2_out[l])
        return rms_norm(h, g_final)

    y_prompt = trunk(x_prompt)
    y_sample = trunk(x_sample)
    return (y_prompt, y_sample)
```

```cpp
#include <hip/hip_runtime.h>
#include <hip/hip_cooperative_groups.h>
#include <cstdio>
#include <cstdint>
namespace cg = cooperative_groups;

#ifndef MK_PER_PHASE
#define MK_PER_PHASE 0
#endif

constexpr int M = 24576, MP = 8192, DM = 2048, FF = 5504, NQKV = 4608, NGATE = 4096, NIN = 8704;
constexpr float EPS = 1e-6f;
constexpr float LOG2E = 1.4426950408889634f;

#define LAS __attribute__((address_space(3)))
typedef unsigned short bf16_t;
typedef short bf16x8 __attribute__((ext_vector_type(8)));
typedef short s16x4 __attribute__((ext_vector_type(4)));
typedef float f32x4 __attribute__((ext_vector_type(4)));
typedef float f32x16 __attribute__((ext_vector_type(16)));
typedef unsigned u32x4 __attribute__((ext_vector_type(4)));
typedef unsigned u32x2 __attribute__((ext_vector_type(2)));
typedef int i32x4 __attribute__((ext_vector_type(4)));

__device__ __forceinline__ unsigned cvt_pk_bf16(float lo, float hi) { unsigned r; asm volatile("v_cvt_pk_bf16_f32 %0, %1, %2" : "=v"(r) : "v"(lo), "v"(hi)); return r; }
__device__ __forceinline__ float bf_lo(unsigned w) { return __uint_as_float(w << 16); }
__device__ __forceinline__ float bf_hi(unsigned w) { return __uint_as_float(w & 0xffff0000u); }
__device__ __forceinline__ float ld_agent(const float* p) { return __hip_atomic_load(p, __ATOMIC_RELAXED, __HIP_MEMORY_SCOPE_AGENT); }
__device__ __forceinline__ float rs_of(const float* ssq, int r) { return __builtin_amdgcn_rsqf(ld_agent(ssq + r) * (1.f / 2048.f) + EPS); }
__device__ __forceinline__ float sigm(float x) { return __builtin_amdgcn_rcpf(1.f + __builtin_amdgcn_exp2f(-LOG2E * x)); }
__device__ __forceinline__ float wave_sum(float v) {
#pragma unroll
    for (int o = 1; o < 64; o <<= 1) v += __shfl_xor(v, o);
    return v;
}

namespace pg8 {
constexpr int BM = 256, BK = 64, HALF = 128, HTB = HALF * BK * 2, STAGE_BYTES = 8 * HTB, NXCD = 8, WGM = 8;
__device__ __forceinline__ int lds_byte(int r, int c) { const int st = (r >> 4) * 2 + (c >> 5), rr = r & 15, cc = c & 31, ob = rr * 64 + cc * 2; return st * 1024 + (ob ^ (((ob >> 9) & 1) << 5)); }
__device__ __forceinline__ void stage_rc(int b, int& R, int& C) { const int st = b / 1024, sb = b % 1024, swz = sb ^ (((sb >> 9) & 1) << 5); R = (st >> 1) * 16 + swz / 64; C = (st & 1) * 32 + (swz % 64) / 2; }
__device__ __forceinline__ int perm32(int rho) { const int n = rho >> 4, i = rho & 15; return 8 * (i >> 2) + 4 * n + (i & 3); }

struct Unit { int pm, pn; };
struct Gemm { const bf16_t* A; const bf16_t* Bt; int M, N, K, lda, ldb; };

struct StaticOrder {
    int nM, nN, nwg, G, c;
    __device__ void init(int M_, int N_, int G_, int c_) { nM = M_ / BM; nN = N_ / BM; nwg = nM * nN; G = G_; c = c_; }
    __device__ bool next(int i, Unit& u) const {
        const long L = (long)i * G + c; if (L >= nwg) return false;
        int wgid = (int)L; { const int q = nwg / NXCD, r = nwg % NXCD, xcd = wgid % NXCD, off = wgid / NXCD; wgid = (xcd < r ? xcd * (q + 1) : r * (q + 1) + (xcd - r) * q) + off; }
        const int nig = WGM * nN, gid = wgid / nig, fm = gid * WGM, gsz = (nM - fm) < WGM ? (nM - fm) : WGM;
        u.pm = fm + ((wgid % nig) % gsz); u.pn = (wgid % nig) / gsz; return true;
    }
};

struct EpiSwiglu {
    static constexpr bool PERM = true, I8 = false; typedef f32x4 acc_t;
    bf16_t* O; const float* ssq;
    __device__ __forceinline__ void operator()(const f32x4 (&acc)[2][2][4][2], const Unit& u, int wr, int wc, int fr, int fq) const {
        const int row0 = u.pm * BM + wr * 64 + fr, col0 = u.pn * HALF + wc * 32 + 8 * fq;
        float sq[8];
#pragma unroll
        for (int g = 0; g < 8; ++g) sq[g] = ld_agent(ssq + row0 + (g >> 2) * HALF + (g & 3) * 16);
#pragma unroll
        for (int ai = 0; ai < 2; ++ai)
#pragma unroll
            for (int m = 0; m < 4; ++m) {
                const int r = row0 + ai * HALF + m * 16; const float rs = __builtin_amdgcn_rsqf(sq[ai * 4 + m] * (1.f / 2048.f) + EPS);
                float v[8];
#pragma unroll
                for (int n = 0; n < 2; ++n)
#pragma unroll
                    for (int j = 0; j < 4; ++j) { const float g = acc[ai][0][m][n][j] * rs, up = acc[ai][1][m][n][j] * rs; v[n * 4 + j] = g * sigm(g) * up; }
                u32x4 w; w.x = cvt_pk_bf16(v[0], v[1]); w.y = cvt_pk_bf16(v[2], v[3]); w.z = cvt_pk_bf16(v[4], v[5]); w.w = cvt_pk_bf16(v[6], v[7]);
                *(u32x4*)(O + (size_t)r * FF + col0) = w;
            }
    }
};
struct EpiSwiglu8 {
    static constexpr bool PERM = true, I8 = true; typedef i32x4 acc_t;
    bf16_t* O; const float* frs; const float* swinv;
    __device__ __forceinline__ void operator()(const i32x4 (&acc)[2][2][4][2], const Unit& u, int wr, int wc, int fr, int fq) const {
        const int row0 = u.pm * BM + wr * 64 + fr, col0 = u.pn * HALF + wc * 32 + 8 * fq, scol = u.pn * BM + wc * 32 + 8 * fq;
        float sq[8];
#pragma unroll
        for (int g = 0; g < 8; ++g) sq[g] = ld_agent(frs + row0 + (g >> 2) * HALF + (g & 3) * 16);
        f32x4 sg[2], su[2];
#pragma unroll
        for (int n = 0; n < 2; ++n) { sg[n] = *(const f32x4*)(swinv + scol + 4 * n); su[n] = *(const f32x4*)(swinv + scol + HALF + 4 * n); }
#pragma unroll
        for (int ai = 0; ai < 2; ++ai)
#pragma unroll
            for (int m = 0; m < 4; ++m) {
                const int r = row0 + ai * HALF + m * 16; const float rs = sq[ai * 4 + m];
                float v[8];
#pragma unroll
                for (int n = 0; n < 2; ++n)
#pragma unroll
                    for (int j = 0; j < 4; ++j) { const float g = (float)acc[ai][0][m][n][j] * rs * sg[n][j], up = (float)acc[ai][1][m][n][j] * rs * su[n][j]; v[n * 4 + j] = g * sigm(g) * up; }
                u32x4 w; w.x = cvt_pk_bf16(v[0], v[1]); w.y = cvt_pk_bf16(v[2], v[3]); w.z = cvt_pk_bf16(v[4], v[5]); w.w = cvt_pk_bf16(v[6], v[7]);
                *(u32x4*)(O + (size_t)r * FF + col0) = w;
            }
    }
};
template <int MODE> struct EpiScaled8 {
    static constexpr bool PERM = true, I8 = true; typedef i32x4 acc_t;
    bf16_t* O; int ldc; const float* fr; const float* swinv; const float* bias;
    __device__ __forceinline__ void operator()(const i32x4 (&acc)[2][2][4][2], const Unit& u, int wr, int wc, int fr_, int fq) const {
        const int row0 = u.pm * BM + wr * 64 + fr_, col0 = u.pn * BM + wc * 32 + 8 * fq;
        f32x4 sw[2][2], bv[2][2];
#pragma unroll
        for (int bj = 0; bj < 2; ++bj)
#pragma unroll
            for (int n = 0; n < 2; ++n) { sw[bj][n] = *(const f32x4*)(swinv + col0 + bj * HALF + 4 * n);
                bv[bj][n] = MODE == 1 ? *(const f32x4*)(bias + col0 + bj * HALF + 4 * n) : (f32x4){0.f, 0.f, 0.f, 0.f}; }
#pragma unroll
        for (int ai = 0; ai < 2; ++ai)
#pragma unroll
            for (int m = 0; m < 4; ++m) {
                asm volatile("" ::: "memory");
                const int r = row0 + ai * HALF + m * 16; const float rs = ld_agent(fr + r);
                bf16_t* rowp = O + (size_t)r * ldc + col0;
#pragma unroll
                for (int bj = 0; bj < 2; ++bj) {
                    f32x4 v0, v1;
#pragma unroll
                    for (int j = 0; j < 4; ++j) { v0[j] = (float)acc[ai][bj][m][0][j] * rs * sw[bj][0][j] + bv[bj][0][j]; v1[j] = (float)acc[ai][bj][m][1][j] * rs * sw[bj][1][j] + bv[bj][1][j]; }
                    if (MODE == 1) {
#pragma unroll
                        for (int j = 0; j < 4; ++j) { v0[j] = sigm(v0[j]); v1[j] = sigm(v1[j]); } }
                    u32x4 w; w.x = cvt_pk_bf16(v0[0], v0[1]); w.y = cvt_pk_bf16(v0[2], v0[3]); w.z = cvt_pk_bf16(v1[0], v1[1]); w.w = cvt_pk_bf16(v1[2], v1[3]);
                    *(u32x4*)(rowp + bj * HALF) = w;
                }
            }
    }
};
struct EpiGates8 {
    static constexpr bool PERM = true, I8 = true; typedef i32x4 acc_t;
    bf16_t* O; int ldc; const float* ssq; const float* bias; const float* swp;
    __device__ __forceinline__ void operator()(const i32x4 (&acc)[2][2][4][2], const Unit& u, int wr, int wc, int fr, int fq) const {
        const int row0 = u.pm * BM + wr * 64 + fr, col0 = u.pn * BM + wc * 32 + 8 * fq;
        f32x4 bv[2][2];
#pragma unroll
        for (int bj = 0; bj < 2; ++bj)
#pragma unroll
            for (int n = 0; n < 2; ++n) bv[bj][n] = *(const f32x4*)(bias + col0 + bj * HALF + 4 * n);
#pragma unroll
        for (int ai = 0; ai < 2; ++ai)
#pragma unroll
            for (int m = 0; m < 4; ++m) {
                const int r = row0 + ai * HALF + m * 16; const float rs = rs_of(ssq, r);
                bf16_t* rowp = O + (size_t)r * ldc + col0;
#pragma unroll
                for (int bj = 0; bj < 2; ++bj) {
                    const f32x4 s0 = *(const f32x4*)(swp + col0 + bj * HALF), s1 = *(const f32x4*)(swp + col0 + bj * HALF + 4);
                    f32x4 v0 = __builtin_convertvector(acc[ai][bj][m][0], f32x4) * s0 * rs + bv[bj][0], v1 = __builtin_convertvector(acc[ai][bj][m][1], f32x4) * s1 * rs + bv[bj][1];
#pragma unroll
                    for (int j = 0; j < 4; ++j) { v0[j] = sigm(v0[j]); v1[j] = sigm(v1[j]); }
                    u32x4 w; w.x = cvt_pk_bf16(v0[0], v0[1]); w.y = cvt_pk_bf16(v0[2], v0[3]); w.z = cvt_pk_bf16(v1[0], v1[1]); w.w = cvt_pk_bf16(v1[2], v1[3]);
                    *(u32x4*)(rowp + bj * HALF) = w;
                }
            }
    }
};
template <int STEP> struct EpiMerge {
    static constexpr bool PERM = true, I8 = false; typedef f32x4 acc_t;
    bf16_t* G;
    __device__ __forceinline__ void operator()(const f32x4 (&acc)[2][2][4][2], const Unit& u, int wr, int wc, int fr, int fq) const {
        const int row0 = u.pm * BM + wr * 64 + fr, col0 = u.pn * BM + wc * 32 + 8 * fq;
        bf16_t* base = G + (size_t)row0 * NGATE + col0;
        u32x4 ga[2], gb[2], na[2], nb[2];
#pragma unroll
        for (int bj = 0; bj < 2; ++bj) { ga[bj] = *(const u32x4*)(base + bj * HALF); if (STEP == 1) gb[bj] = *(const u32x4*)(base + bj * HALF + DM); }
#pragma unroll
        for (int g = 0; g < 8; ++g) {
            const int ai = g >> 2, m = g & 3;
            bf16_t* rowp = base + (size_t)(ai * HALF + m * 16) * NGATE;
            if (g < 7) { const bf16_t* nrow = base + (size_t)(((g + 1) >> 2) * HALF + ((g + 1) & 3) * 16) * NGATE;
#pragma unroll
                for (int bj = 0; bj < 2; ++bj) { na[bj] = *(const u32x4*)(nrow + bj * HALF); if (STEP == 1) nb[bj] = *(const u32x4*)(nrow + bj * HALF + DM); } }
#pragma unroll
            for (int bj = 0; bj < 2; ++bj) {
                const f32x4 a0 = acc[ai][bj][m][0], a1 = acc[ai][bj][m][1];
                float v[8];
                if (STEP == 0) {
                    v[0] = bf_lo(ga[bj].x) * a0[0]; v[1] = bf_hi(ga[bj].x) * a0[1]; v[2] = bf_lo(ga[bj].y) * a0[2]; v[3] = bf_hi(ga[bj].y) * a0[3];
                    v[4] = bf_lo(ga[bj].z) * a1[0]; v[5] = bf_hi(ga[bj].z) * a1[1]; v[6] = bf_lo(ga[bj].w) * a1[2]; v[7] = bf_hi(ga[bj].w) * a1[3];
                } else {
                    v[0] = bf_lo(ga[bj].x) + bf_lo(gb[bj].x) * a0[0]; v[1] = bf_hi(ga[bj].x) + bf_hi(gb[bj].x) * a0[1]; v[2] = bf_lo(ga[bj].y) + bf_lo(gb[bj].y) * a0[2]; v[3] = bf_hi(ga[bj].y) + bf_hi(gb[bj].y) * a0[3];
                    v[4] = bf_lo(ga[bj].z) + bf_lo(gb[bj].z) * a1[0]; v[5] = bf_hi(ga[bj].z) + bf_hi(gb[bj].z) * a1[1]; v[6] = bf_lo(ga[bj].w) + bf_lo(gb[bj].w) * a1[2]; v[7] = bf_hi(ga[bj].w) + bf_hi(gb[bj].w) * a1[3];
                }
                u32x4 w; w.x = cvt_pk_bf16(v[0], v[1]); w.y = cvt_pk_bf16(v[2], v[3]); w.z = cvt_pk_bf16(v[4], v[5]); w.w = cvt_pk_bf16(v[6], v[7]);
                *(u32x4*)(rowp + bj * HALF) = w;
            }
            asm volatile("" ::: "memory");
#pragma unroll
            for (int bj = 0; bj < 2; ++bj) { ga[bj] = na[bj]; if (STEP == 1) gb[bj] = nb[bj]; }
        }
    }
};
template <bool WITH_HB, bool WITH_SSQ> struct EpiResid {
    static constexpr bool PERM = false, I8 = false; typedef f32x4 acc_t;
    const float* base_lo; const float* base_hi; float* out; bf16_t* hb; float* ssq; float alpha;
    __device__ __forceinline__ void operator()(const f32x4 (&acc)[2][2][4][2], const Unit& u, int wr, int wc, int fr, int fq) const {
        const int row0 = u.pm * BM + wr * 64 + fr, col0 = u.pn * BM + wc * 32 + 4 * fq;
        const float* base = ((u.pm < MP / BM) ? base_lo : base_hi - (size_t)MP * DM) + (size_t)row0 * DM + col0;
        f32x4 b[2][2], nb[2][2];
#pragma unroll
        for (int bj = 0; bj < 2; ++bj)
#pragma unroll
            for (int n = 0; n < 2; ++n) b[bj][n] = *(const f32x4*)(base + bj * HALF + n * 16);
#pragma unroll
        for (int g = 0; g < 8; ++g) {
            const int ai = g >> 2, m = g & 3;
            const int r = row0 + ai * HALF + m * 16; const size_t off = (size_t)r * DM + col0; float s = 0.f;
            if (g < 7) { const float* nrow = base + (size_t)(((g + 1) >> 2) * HALF + ((g + 1) & 3) * 16) * DM;
#pragma unroll
                for (int bj = 0; bj < 2; ++bj)
#pragma unroll
                    for (int n = 0; n < 2; ++n) nb[bj][n] = *(const f32x4*)(nrow + bj * HALF + n * 16); }
#pragma unroll
            for (int bj = 0; bj < 2; ++bj)
#pragma unroll
                for (int n = 0; n < 2; ++n) {
                    const f32x4 o = b[bj][n] + acc[ai][bj][m][n] * alpha;
                    *(f32x4*)(out + off + bj * HALF + n * 16) = o;
                    if (WITH_SSQ) s += (o[0] * o[0] + o[1] * o[1]) + (o[2] * o[2] + o[3] * o[3]);
                    if (WITH_HB) { u32x2 w; w.x = cvt_pk_bf16(o[0], o[1]); w.y = cvt_pk_bf16(o[2], o[3]); *(u32x2*)(hb + off + bj * HALF + n * 16) = w; }
                }
            if (WITH_SSQ) { s += __shfl_xor(s, 16); s += __shfl_xor(s, 32); if (fq == 0) atomicAdd(ssq + r, s); }
            asm volatile("" ::: "memory");
#pragma unroll
            for (int bj = 0; bj < 2; ++bj)
#pragma unroll
                for (int n = 0; n < 2; ++n) b[bj][n] = nb[bj][n];
        }
    }
};

template <bool I8> struct MmaOp;
template <> struct MmaOp<false> { static __device__ __forceinline__ f32x4 run(bf16x8 a, bf16x8 b, f32x4 c) { return __builtin_amdgcn_mfma_f32_16x16x32_bf16(a, b, c, 0, 0, 0); } };
template <> struct MmaOp<true> { static __device__ __forceinline__ i32x4 run(bf16x8 a, bf16x8 b, i32x4 c) { return __builtin_amdgcn_mfma_i32_16x16x64_i8(__builtin_bit_cast(i32x4, a), __builtin_bit_cast(i32x4, b), c, 0, 0, 0); } };
template <class Epi, class Sched>
__device__ __forceinline__ void gemm_phase(LAS unsigned char* lds, const Gemm g, const Sched& S, const Epi& E) {
    const int tid = threadIdx.x, wid = __builtin_amdgcn_readfirstlane(tid >> 6), lane = tid & 63, wr = wid >> 2, wc = wid & 3, fr = lane & 15, fq = lane >> 4;
    const int K = g.K, nt = K / BK;
    unsigned voffA[2], voffB[2];
#pragma unroll
    for (int i = 0; i < 2; ++i) { int R, C; stage_rc(tid * 16 + i * 8192, R, C); const int Rb = Epi::PERM ? ((R & ~31) + perm32(R & 31)) : R;
        voffA[i] = (unsigned)(R * g.lda + C) * 2u; voffB[i] = (unsigned)(Rb * g.ldb + C) * 2u; }
    const size_t kstep = (size_t)(BK * 2);
    const size_t hstepA = (size_t)HALF * g.lda * 2, hstepB = (size_t)HALF * g.ldb * 2;
    const size_t tstepA = 2 * hstepA, tstepB = 2 * hstepB;
    const unsigned ldsw = (unsigned)wid * 1024u;
    const int aoff = lds_byte(wr * 64 + fr, fq * 8), boff = lds_byte(wc * 32 + fr, fq * 8);
#define PG8_SA(b, h) (((b) * 2 + (h)) * HTB)
#define PG8_SB(b, h) ((4 + (b) * 2 + (h)) * HTB)
#define PG8_STAGE(bufoff, gbase, voff) do { _Pragma("unroll") for (int _i = 0; _i < 2; ++_i) \
        __builtin_amdgcn_global_load_lds((const unsigned*)((const char*)(gbase) + (voff)[_i]), (LAS unsigned*)(lds + (bufoff) + ldsw + _i * 8192), 16, 0, 0); } while (0)
#define PG8_LDA(dst, b, h) do { _Pragma("unroll") for (int m = 0; m < 4; ++m) _Pragma("unroll") for (int k = 0; k < 2; ++k) dst[m][k] = *(const LAS bf16x8*)(lds + PG8_SA(b, h) + aoff + m * 2048 + k * 1024); } while (0)
#define PG8_LDB(dst, b, h) do { _Pragma("unroll") for (int n = 0; n < 2; ++n) _Pragma("unroll") for (int k = 0; k < 2; ++k) dst[n][k] = *(const LAS bf16x8*)(lds + PG8_SB(b, h) + boff + n * 2048 + k * 1024); } while (0)
#define PG8_MMA(ai, bj, At, Bt) do { __builtin_amdgcn_s_setprio(1); _Pragma("unroll") for (int m = 0; m < 4; ++m) _Pragma("unroll") for (int n = 0; n < 2; ++n) _Pragma("unroll") for (int k = 0; k < 2; ++k) \
        acc[ai][bj][m][n] = MmaOp<Epi::I8>::run(Bt[n][k], At[m][k], acc[ai][bj][m][n]); __builtin_amdgcn_s_setprio(0); } while (0)
#define PG8_WAIT_V(n) asm volatile("s_waitcnt vmcnt(" #n ")" ::: "memory")
#define PG8_WAIT_L(n) asm volatile("s_waitcnt lgkmcnt(" #n ")" ::: "memory")
#define PG8_BAR __builtin_amdgcn_s_barrier()
#define PG8_SCHED __builtin_amdgcn_sched_barrier(0)
    Unit cur, nxt; int ui = 0;
    if (!S.next(0, cur)) return;
    typedef typename Epi::acc_t acc_t;
    acc_t acc[2][2][4][2];
#pragma unroll
    for (int a = 0; a < 2; ++a)
#pragma unroll
        for (int b = 0; b < 2; ++b)
#pragma unroll
            for (int m = 0; m < 4; ++m)
#pragma unroll
                for (int n = 0; n < 2; ++n) acc[a][b][m][n] = (acc_t){0, 0, 0, 0};
    bf16x8 At[4][2], B0[2][2], B1[2][2];
    const char* cA = (const char*)g.A + (size_t)cur.pm * tstepA; const char* cB = (const char*)g.Bt + (size_t)cur.pn * tstepB;
    PG8_STAGE(PG8_SB(0, 0), cB, voffB); PG8_STAGE(PG8_SA(0, 0), cA, voffA); PG8_STAGE(PG8_SB(0, 1), cB + hstepB, voffB); PG8_STAGE(PG8_SA(0, 1), cA + hstepA, voffA);
    if (wr == 1) PG8_BAR;
    PG8_WAIT_V(4); PG8_BAR;
    PG8_STAGE(PG8_SB(1, 0), cB + kstep, voffB); PG8_STAGE(PG8_SA(1, 0), cA + kstep, voffA); PG8_STAGE(PG8_SB(1, 1), cB + hstepB + kstep, voffB);
    PG8_WAIT_V(6); PG8_BAR;
    for (;;) {
        const bool has_next = S.next(ui + 1, nxt);
        const char* nA = has_next ? (const char*)g.A + (size_t)nxt.pm * tstepA : cA; const char* nB = has_next ? (const char*)g.Bt + (size_t)nxt.pn * tstepB : cB;
        for (int t = 0; t < nt; t += 2) {
            const bool last = (t == nt - 2);
            const char* a1 = cA + (size_t)(t + 1) * kstep;
            const char* a2 = last ? nA : cA + (size_t)(t + 2) * kstep; const char* b2 = last ? nB : cB + (size_t)(t + 2) * kstep;
            const char* a3 = a2 + kstep; const char* b3 = b2 + kstep;
            PG8_LDB(B0, 0, 0); PG8_SCHED; PG8_LDA(At, 0, 0); PG8_STAGE(PG8_SA(1, 1), a1 + hstepA, voffA);
            PG8_WAIT_L(8); PG8_BAR; PG8_WAIT_L(0); PG8_MMA(0, 0, At, B0); PG8_BAR; PG8_SCHED;
            PG8_LDB(B1, 0, 1); PG8_STAGE(PG8_SB(0, 0), b2, voffB);
            PG8_BAR; PG8_WAIT_L(0); PG8_MMA(0, 1, At, B1); PG8_BAR;
            PG8_LDA(At, 0, 1); PG8_STAGE(PG8_SA(0, 0), a2, voffA);
            PG8_BAR; PG8_WAIT_L(0); PG8_MMA(1, 0, At, B0); PG8_BAR; PG8_SCHED;
            PG8_STAGE(PG8_SB(0, 1), b2 + hstepB, voffB);
            PG8_WAIT_V(6); PG8_BAR; PG8_MMA(1, 1, At, B1); PG8_BAR;
            PG8_LDB(B0, 1, 0); PG8_SCHED; PG8_LDA(At, 1, 0); PG8_STAGE(PG8_SA(0, 1), a2 + hstepA, voffA);
            PG8_WAIT_L(8); PG8_BAR; PG8_WAIT_L(0); PG8_MMA(0, 0, At, B0); PG8_BAR; PG8_SCHED;
            PG8_LDB(B1, 1, 1); PG8_STAGE(PG8_SB(1, 0), b3, voffB);
            PG8_BAR; PG8_WAIT_L(0); PG8_MMA(0, 1, At, B1); PG8_BAR;
            PG8_LDA(At, 1, 1); PG8_STAGE(PG8_SA(1, 0), a3, voffA);
            PG8_BAR; PG8_WAIT_L(0); PG8_MMA(1, 0, At, B0); PG8_BAR; PG8_SCHED;
            PG8_STAGE(PG8_SB(1, 1), b3 + hstepB, voffB);
            PG8_WAIT_V(6); PG8_BAR; PG8_MMA(1, 1, At, B1); PG8_BAR;
        }
        E(acc, cur, wr, wc, fr, fq);
        if (!has_next) break;
#pragma unroll
        for (int a = 0; a < 2; ++a)
#pragma unroll
            for (int b = 0; b < 2; ++b)
#pragma unroll
                for (int m = 0; m < 4; ++m)
#pragma unroll
                    for (int n = 0; n < 2; ++n) acc[a][b][m][n] = (acc_t){0, 0, 0, 0};
        cur = nxt; cA = nA; cB = nB; ++ui;
    }
    PG8_WAIT_V(0);
    if (wr == 0) PG8_BAR;
    PG8_BAR;
#undef PG8_SA
#undef PG8_SB
#undef PG8_STAGE
#undef PG8_LDA
#undef PG8_LDB
#undef PG8_MMA
#undef PG8_WAIT_V
#undef PG8_WAIT_L
#undef PG8_BAR
#undef PG8_SCHED
}
}

namespace att {
constexpr int D = 128, NW = 8, QBLK = 32, KVBLK = 64;
constexpr float SCALE = 0.088388347648318440f;
constexpr float THR = 8.f;
constexpr int LDQ = NQKV, LDK = NQKV, LDO = DM;
constexpr size_t SHM_V = KVBLK * D * 2, SHM_K = KVBLK * D * 2;
constexpr size_t SHM_WS = 2 * SHM_V + 2 * SHM_K, SHM_RPB = SHM_WS + NW * 64 * 4, SHM_ATTN = SHM_RPB + 512 * 4;
#define KSWZ(row, colB) ((row) * 256 + ((colB) ^ (((row) & 7) << 4)))
#define SBAR() __builtin_amdgcn_sched_barrier(0)
__device__ __forceinline__ int crow(int r, int hi) { return (r & 3) + 8 * (r >> 2) + 4 * hi; }
__device__ __forceinline__ bf16x8 ld8(const bf16_t* p) { return *reinterpret_cast<const bf16x8*>(p); }

__device__ __forceinline__ void partialSM(f32x16& p0, f32x16& p1, float& m_reg, float& mn, float& alpha) {
    constexpr float C = SCALE * LOG2E;
    float pmax = p0[0];
#pragma unroll
    for (int r = 1; r < 16; ++r) pmax = fmaxf(pmax, p0[r]);
#pragma unroll
    for (int r = 0; r < 16; ++r) pmax = fmaxf(pmax, p1[r]);
    { auto rr = __builtin_amdgcn_permlane32_swap(__float_as_uint(pmax), __float_as_uint(pmax), false, false);
      pmax = fmaxf(__uint_as_float(rr[0]), __uint_as_float(rr[1])); }
    if (__builtin_expect(__all(pmax - m_reg <= THR / SCALE), 1)) { mn = m_reg; alpha = 1.f; }
    else { mn = fmaxf(m_reg, pmax); alpha = __builtin_amdgcn_exp2f((m_reg - mn) * C); m_reg = mn; }
    const float mnC = -mn * C;
#pragma unroll
    for (int r = 0; r < 16; ++r) p0[r] = fmaf(p0[r], C, mnC);
#pragma unroll
    for (int r = 0; r < 16; ++r) p1[r] = fmaf(p1[r], C, mnC);
#pragma unroll
    for (int r = 0; r < 16; ++r) p0[r] = __builtin_amdgcn_exp2f(p0[r]);
}
#define PK4(P, BASE, OUT) do { unsigned a0 = cvt_pk_bf16(P[BASE + 0], P[BASE + 1]), a1 = cvt_pk_bf16(P[BASE + 2], P[BASE + 3]);   \
    unsigned b0 = cvt_pk_bf16(P[BASE + 4], P[BASE + 5]), b1 = cvt_pk_bf16(P[BASE + 6], P[BASE + 7]);                              \
    auto r0 = __builtin_amdgcn_permlane32_swap(a0, b0, false, false); auto r1 = __builtin_amdgcn_permlane32_swap(a1, b1, false, false); \
    u32x4 w = {r0[0], r1[0], r0[1], r1[1]}; OUT = *reinterpret_cast<bf16x8*>(&w); } while (0)
__device__ __forceinline__ void finishSM(f32x16& p0, f32x16& p1, float alpha, float& l_reg, bf16x8& pa0, bf16x8& pa1, bf16x8& pa2, bf16x8& pa3) {
#pragma unroll
    for (int r = 0; r < 16; ++r) p1[r] = __builtin_amdgcn_exp2f(p1[r]);
    float ps = 0;
#pragma unroll
    for (int r = 0; r < 16; ++r) ps += p0[r];
#pragma unroll
    for (int r = 0; r < 16; ++r) ps += p1[r];
    { auto rr = __builtin_amdgcn_permlane32_swap(__float_as_uint(ps), __float_as_uint(ps), false, false);
      ps = __uint_as_float(rr[0]) + __uint_as_float(rr[1]); }
    l_reg = l_reg * alpha + ps;
    PK4(p0, 0, pa0); PK4(p0, 8, pa1); PK4(p1, 0, pa2); PK4(p1, 8, pa3);
}
__device__ __forceinline__ void qkt(f32x16& p0, f32x16& p1, const bf16_t* Ks, const bf16x8* qr, int r32, int hi) {
    p0 = f32x16{}; p1 = f32x16{};
#pragma unroll
    for (int d0 = 0; d0 < 8; ++d0) { const int cb = (d0 * 16 + hi * 8) * 2;
        bf16x8 b0 = *reinterpret_cast<const bf16x8*>((const char*)Ks + KSWZ(r32, cb));
        bf16x8 b1 = *reinterpret_cast<const bf16x8*>((const char*)Ks + KSWZ(32 + r32, cb));
        p0 = __builtin_amdgcn_mfma_f32_32x32x16_bf16(b0, qr[d0], p0, 0, 0, 0);
        p1 = __builtin_amdgcn_mfma_f32_32x32x16_bf16(b1, qr[d0], p1, 0, 0, 0); }
}
__device__ __forceinline__ int v_st(int k, int c) { const int kk = (k & ~0xC) | ((k & 4) << 1) | ((k & 8) >> 1); return ((kk >> 3) * 4 + (c >> 5)) * 512 + ((kk & 7) * 32 + (c & 31)) * 2; }
__device__ __forceinline__ int v_rd_base(int lane) { return ((lane & 3) << 3) | (((lane >> 2) & 3) << 6) | (((lane >> 4) & 1) << 5) | (((lane >> 5) & 1) << 8); }
constexpr int v_rd_off(int d0, int ks, int half) { return d0 * 512 + ks * 4096 + half * 2048; }
template <int OFF> __device__ __forceinline__ s16x4 tr_read(int vb) {
    s16x4 r; asm volatile("ds_read_b64_tr_b16 %0, %1 offset:%2" : "=&v"(r) : "v"(vb), "i"(OFF) : "memory"); return r;
}
template <int D0> __device__ __forceinline__ void pv_one(f32x16& od, int vb, bf16x8 pa0, bf16x8 pa1, bf16x8 pa2, bf16x8 pa3) {
    const s16x4 l0 = tr_read<v_rd_off(D0, 0, 0)>(vb), h0 = tr_read<v_rd_off(D0, 0, 1)>(vb), l1 = tr_read<v_rd_off(D0, 1, 0)>(vb), h1 = tr_read<v_rd_off(D0, 1, 1)>(vb);
    const s16x4 l2 = tr_read<v_rd_off(D0, 2, 0)>(vb), h2 = tr_read<v_rd_off(D0, 2, 1)>(vb), l3 = tr_read<v_rd_off(D0, 3, 0)>(vb), h3 = tr_read<v_rd_off(D0, 3, 1)>(vb);
    asm volatile("s_waitcnt lgkmcnt(0)" ::: "memory"); SBAR();
#define PKV(L, H) (bf16x8){L[0], L[1], L[2], L[3], H[0], H[1], H[2], H[3]}
    od = __builtin_amdgcn_mfma_f32_32x32x16_bf16(pa0, PKV(l0, h0), od, 0, 0, 0);
    od = __builtin_amdgcn_mfma_f32_32x32x16_bf16(pa1, PKV(l1, h1), od, 0, 0, 0);
    od = __builtin_amdgcn_mfma_f32_32x32x16_bf16(pa2, PKV(l2, h2), od, 0, 0, 0);
    od = __builtin_amdgcn_mfma_f32_32x32x16_bf16(pa3, PKV(l3, h3), od, 0, 0, 0);
#undef PKV
}
__device__ __forceinline__ void pv_d0(f32x16* o, int vb, bf16x8 pa0, bf16x8 pa1, bf16x8 pa2, bf16x8 pa3) {
    pv_one<0>(o[0], vb, pa0, pa1, pa2, pa3); pv_one<1>(o[1], vb, pa0, pa1, pa2, pa3); pv_one<2>(o[2], vb, pa0, pa1, pa2, pa3); pv_one<3>(o[3], vb, pa0, pa1, pa2, pa3);
}

__device__ __forceinline__ void attn_dense_body(const bf16_t* Qb, const bf16_t* Kh, const bf16_t* Vh, bf16_t* Ob, int seq, char* lds) {
    int tid_ = threadIdx.x; asm volatile("" : "+v"(tid_));
    const int tid = tid_, wid = tid >> 6, lane = tid & 63, r32 = lane & 31, hi = lane >> 5;
    bf16_t* V_lds = (bf16_t*)lds; bf16_t* K_lds = (bf16_t*)(lds + 2 * SHM_V);
    float* ws = (float*)(lds + SHM_WS) + wid * 64; float* li_l = ws; float* al_l = ws + 32;
    float m_reg = -1e30f, l_reg = 0; f32x16 o[4] = {}; bf16x8 qr[8];
    const bf16_t* Qw = Qb + (long)(wid * QBLK + r32) * LDQ + hi * 8;
#pragma unroll
    for (int d0 = 0; d0 < 8; ++d0) qr[d0] = ld8(Qw + d0 * 16);
    const int sr = tid >> 4, sc = (tid & 15) * 8, vst0 = v_st(sr, sc), vst1 = v_st(32 + sr, sc);
    const int vb0 = (int)(uintptr_t)V_lds + v_rd_base(lane);
    struct { bf16x8 vs0, vs1, ks0, ks1; } sr_[2];
#define SLOAD(i, k0) do { sr_[i].vs0 = ld8(&Vh[(long)((k0) + sr) * LDK + sc]); sr_[i].vs1 = ld8(&Vh[(long)((k0) + 32 + sr) * LDK + sc]); \
    sr_[i].ks0 = ld8(&Kh[(long)((k0) + sr) * LDK + sc]); sr_[i].ks1 = ld8(&Kh[(long)((k0) + 32 + sr) * LDK + sc]); } while (0)
#define SWRITE(b, i) do { *(bf16x8*)((char*)V_lds + (b) * SHM_V + vst0) = sr_[i].vs0;          \
    *(bf16x8*)((char*)V_lds + (b) * SHM_V + vst1) = sr_[i].vs1; int kc = sc * 2;               \
    *(bf16x8*)((char*)K_lds + (b) * SHM_K + KSWZ(sr, kc)) = sr_[i].ks0;                       \
    *(bf16x8*)((char*)K_lds + (b) * SHM_K + KSWZ(32 + sr, kc)) = sr_[i].ks1; } while (0)
#define SWAIT() asm volatile("s_waitcnt vmcnt(4)" ::: "memory")
#define RESC(a) do { if (__any((a) < 1.f)) { if (hi == 0) al_l[r32] = (a); asm volatile("s_waitcnt lgkmcnt(0)" ::: "memory"); \
    _Pragma("unroll") for (int d = 0; d < 4; ++d) _Pragma("unroll") for (int r = 0; r < 16; ++r) o[d][r] *= al_l[crow(r, hi)]; } } while (0)
    f32x16 pA0, pA1, pB0, pB1; float mnA, mnB, alA, alB; bf16x8 pa0, pa1, pa2, pa3; const int NT = seq / KVBLK;
    constexpr int SE = 0, SO = 1;
    SLOAD(SE, 0); asm volatile("s_waitcnt vmcnt(0)" ::: "memory"); SWRITE(0, SE); __syncthreads();
    qkt(pA0, pA1, K_lds, qr, r32, hi); partialSM(pA0, pA1, m_reg, mnA, alA);
    SLOAD(SO, KVBLK); if (2 < NT) SLOAD(SE, 2 * KVBLK);
    SWAIT(); SWRITE(1, SO); __syncthreads();
    for (int j = 1; j + 1 < NT; j += 2) {
        SBAR(); qkt(pB0, pB1, (bf16_t*)((char*)K_lds + SHM_K), qr, r32, hi);
        finishSM(pA0, pA1, alA, l_reg, pa0, pa1, pa2, pa3); SBAR();
        SLOAD(SO, (j + 2) * KVBLK); SBAR();
        pv_d0(o, vb0, pa0, pa1, pa2, pa3); partialSM(pB0, pB1, m_reg, mnB, alB);
        __syncthreads(); SWAIT(); SWRITE(0, SE);
        RESC(alB); __syncthreads();
        SBAR(); qkt(pA0, pA1, K_lds, qr, r32, hi);
        finishSM(pB0, pB1, alB, l_reg, pa0, pa1, pa2, pa3); SBAR();
        if (j + 3 < NT) SLOAD(SE, (j + 3) * KVBLK); SBAR();
        pv_d0(o, vb0 + (int)SHM_V, pa0, pa1, pa2, pa3); partialSM(pA0, pA1, m_reg, mnA, alA);
        __syncthreads(); SWAIT(); SWRITE(1, SO);
        RESC(alA); __syncthreads();
    }
    SBAR(); qkt(pB0, pB1, (bf16_t*)((char*)K_lds + SHM_K), qr, r32, hi);
    finishSM(pA0, pA1, alA, l_reg, pa0, pa1, pa2, pa3); SBAR();
    pv_d0(o, vb0, pa0, pa1, pa2, pa3); partialSM(pB0, pB1, m_reg, mnB, alB);
    __syncthreads(); RESC(alB);
    finishSM(pB0, pB1, alB, l_reg, pa0, pa1, pa2, pa3); SBAR();
    pv_d0(o, vb0 + (int)SHM_V, pa0, pa1, pa2, pa3);
    if (hi == 0) li_l[r32] = l_reg; asm volatile("s_waitcnt lgkmcnt(0)" ::: "memory");
    int r32e = r32, hie = hi; asm volatile("" : "+v"(r32e), "+v"(hie));
    bf16_t* Ow = Ob + (long)(wid * QBLK) * LDO;
#pragma unroll
    for (int r = 0; r < 16; ++r) { const int orow = crow(r, hie); const float rl = __builtin_amdgcn_rcpf(li_l[orow]);
#pragma unroll
        for (int d0 = 0; d0 < 4; ++d0) Ow[(long)orow * LDO + d0 * 32 + r32e] = (bf16_t)(cvt_pk_bf16(o[d0][r] * rl, 0.f) & 0xffffu); }
#undef SLOAD
#undef SWRITE
#undef SWAIT
#undef RESC
}

__device__ __forceinline__ void na_unit(const bf16_t* QKV, bf16_t* YAB, const float* rpb, int rb, int h, char* lds) {
    int tid_ = threadIdx.x; asm volatile("" : "+v"(tid_));
    const int tid = tid_, wid = __builtin_amdgcn_readfirstlane(tid >> 6), lane = tid & 63, r32 = lane & 31, hi = lane >> 5;
    bf16_t* V_lds = (bf16_t*)lds; bf16_t* K_lds = (bf16_t*)(lds + 2 * SHM_V);
    float* wsf = (float*)(lds + SHM_WS) + wid * 64; float* li_l = wsf; float* al_l = wsf + 32;
    float* rp = (float*)(lds + SHM_RPB);
    const int tok0 = rb * 256;
    int tb, R;
    if (tok0 < MP) { tb = tok0 & ~4095; R = 64; } else { tb = MP + ((tok0 - MP) & ~2047); R = 32; }
    const int r0 = (tok0 - tb) >> 6;
    const int r = r0 + (wid >> 1), g = wid & 1, qc = g * 32 + r32;
    const int rs_w = min(max(r - 4, 0), R - 8);
    const int lo = min(max(r0 - 4, 0), R - 8), hiT = min(max(r0 - 1, 0), R - 8) + 8, ntile = hiT - lo;
    const int cs = min(max(qc - 8, 0), 48);
    __syncthreads();
    for (int i = tid; i < 465; i += 512) rp[i] = rpb[h * 465 + i] * LOG2E;
    bf16x8 qr[8];
    { const bf16_t* Qw = QKV + (size_t)(tb + r * 64 + qc) * LDQ + 1536 + h * 128 + hi * 8;
#pragma unroll
      for (int d0 = 0; d0 < 8; ++d0) qr[d0] = ld8(Qw + d0 * 16); }
    const bf16_t* Kh = QKV + (size_t)tb * LDQ + 2560 + h * 128; const bf16_t* Vh = QKV + (size_t)tb * LDQ + 3584 + h * 128;
    const int sr = tid >> 4, sc = (tid & 15) * 8, vst0 = v_st(sr, sc), vst1 = v_st(32 + sr, sc);
    const int vb0 = (int)(uintptr_t)V_lds + v_rd_base(lane);
    bf16x8 vs0, vs1, ks0, ks1;
#define NLOAD(kr) do { const long k0 = (long)(kr) * 64; vs0 = ld8(&Vh[(k0 + sr) * LDK + sc]); vs1 = ld8(&Vh[(k0 + 32 + sr) * LDK + sc]); \
    ks0 = ld8(&Kh[(k0 + sr) * LDK + sc]); ks1 = ld8(&Kh[(k0 + 32 + sr) * LDK + sc]); } while (0)
#define NWRITE(b) do { *(bf16x8*)((char*)V_lds + (b) * SHM_V + vst0) = vs0; *(bf16x8*)((char*)V_lds + (b) * SHM_V + vst1) = vs1; \
    *(bf16x8*)((char*)K_lds + (b) * SHM_K + KSWZ(sr, sc * 2)) = ks0; *(bf16x8*)((char*)K_lds + (b) * SHM_K + KSWZ(32 + sr, sc * 2)) = ks1; } while (0)
    NLOAD(lo);
    float m_reg = -1e30f, l_reg = 0.f; f32x16 o[4] = {};
    constexpr float C = SCALE * LOG2E;
    for (int t = 0; t < ntile; ++t) {
        const int kr = lo + t, b = t & 1;
        NWRITE(b);
        if (t + 1 < ntile) NLOAD(kr + 1);
        __syncthreads();
        if (kr >= rs_w && kr < rs_w + 8) {
            f32x16 p0, p1;
            qkt(p0, p1, (const bf16_t*)((const char*)K_lds + b * SHM_K), qr, r32, hi);
            const float* rprow = rp + (kr - r + 7) * 31;
            float pmax = -1e30f;
#pragma unroll
            for (int rr = 0; rr < 16; ++rr) {
                const int kc0 = crow(rr, hi), kc1 = kc0 + 32;
                const bool v0 = (kc0 >= cs) && (kc0 < cs + 16), v1 = (kc1 >= cs) && (kc1 < cs + 16);
                const float b0 = rprow[min(max(kc0 - qc + 15, 0), 30)], b1 = rprow[min(max(kc1 - qc + 15, 0), 30)];
                p0[rr] = v0 ? fmaf(p0[rr], C, b0) : -1e30f; p1[rr] = v1 ? fmaf(p1[rr], C, b1) : -1e30f;
                pmax = fmaxf(pmax, fmaxf(p0[rr], p1[rr]));
            }
            { auto sw = __builtin_amdgcn_permlane32_swap(__float_as_uint(pmax), __float_as_uint(pmax), false, false);
              pmax = fmaxf(__uint_as_float(sw[0]), __uint_as_float(sw[1])); }
            const float mn = fmaxf(m_reg, pmax), alpha = __builtin_amdgcn_exp2f(m_reg - mn); m_reg = mn;
            float ps = 0.f;
#pragma unroll
            for (int rr = 0; rr < 16; ++rr) { p0[rr] = __builtin_amdgcn_exp2f(p0[rr] - mn); p1[rr] = __builtin_amdgcn_exp2f(p1[rr] - mn); ps += p0[rr] + p1[rr]; }
            { auto sw = __builtin_amdgcn_permlane32_swap(__float_as_uint(ps), __float_as_uint(ps), false, false);
              ps = __uint_as_float(sw[0]) + __uint_as_float(sw[1]); }
            l_reg = l_reg * alpha + ps;
            if (hi == 0) al_l[r32] = alpha;
            asm volatile("s_waitcnt lgkmcnt(0)" ::: "memory");
#pragma unroll
            for (int d = 0; d < 4; ++d)
#pragma unroll
                for (int rr = 0; rr < 16; ++rr) o[d][rr] *= al_l[crow(rr, hi)];
            bf16x8 pa0, pa1, pa2, pa3;
            PK4(p0, 0, pa0); PK4(p0, 8, pa1); PK4(p1, 0, pa2); PK4(p1, 8, pa3);
            pv_d0(o, vb0 + b * (int)SHM_V, pa0, pa1, pa2, pa3);
        }
    }
    if (hi == 0) li_l[r32] = l_reg; asm volatile("s_waitcnt lgkmcnt(0)" ::: "memory");
    int r32e = r32, hie = hi; asm volatile("" : "+v"(r32e), "+v"(hie));
    bf16_t* Ow = YAB + (size_t)(tb + r * 64 + g * 32) * LDO + 1024 + h * 128;
#pragma unroll
    for (int rr = 0; rr < 16; ++rr) { const int orow = crow(rr, hie); const float rl = __builtin_amdgcn_rcpf(li_l[orow]);
#pragma unroll
        for (int d0 = 0; d0 < 4; ++d0) Ow[(long)orow * LDO + d0 * 32 + r32e] = (bf16_t)(cvt_pk_bf16(o[d0][rr] * rl, 0.f) & 0xffffu); }
#undef NLOAD
#undef NWRITE
}
}


#define XB_TMO      128
#define XB_XCNT(j)  (256  + 64 * (j))
#define XB_XSUB(j)  (1280 + 64 * (j))
#define XB_XGEN(j)  (2304 + 64 * (j))
#define XB_TOP      3328
#define XB_TOPGEN   3392
#define XCD_BAR_WORDS 3456
#define XB_SPIN_CAP (1u << 18)
__device__ __forceinline__ unsigned xb_ld(unsigned* p)              { return __hip_atomic_load(p, __ATOMIC_RELAXED, __HIP_MEMORY_SCOPE_AGENT); }
__device__ __forceinline__ unsigned xb_add(unsigned* p, unsigned v) { return __hip_atomic_fetch_add(p, v, __ATOMIC_RELAXED, __HIP_MEMORY_SCOPE_AGENT); }
__device__ __forceinline__ unsigned xb_xcc_id() { return (unsigned)__builtin_amdgcn_s_getreg((3 << 11) | 20) & 0xFu; }
#define XB_SPIN(cond, bar) do { unsigned _sp = 0; while (cond) { __builtin_amdgcn_s_sleep(1); \
    if ((++_sp & 255u) == 0u) { if (xb_ld(&(bar)[XB_TMO])) break; if (_sp > XB_SPIN_CAP) { atomicAdd(&(bar)[XB_TMO], 1u); break; } } } } while (0)
struct XcdBarrier { unsigned* bar; unsigned x; volatile LAS unsigned* st; };
__device__ __forceinline__ XcdBarrier xcd_barrier_post(unsigned* bar, volatile LAS unsigned* st) {
    XcdBarrier b; b.bar = bar; b.x = xb_xcc_id(); b.st = st;
    if (threadIdx.x == 0) (void)xb_add(&bar[XB_XCNT(b.x)], 1u);
    return b;
}
__device__ __forceinline__ void xcd_barrier_complete(unsigned* bar, unsigned x, unsigned& nloc, unsigned& nx) {
    const unsigned G = gridDim.x * gridDim.y * gridDim.z;
    unsigned sum, cnt, mine, sp = 0u;
    for (;;) {
        sum = 0u; cnt = 0u; mine = 0u;
#pragma unroll
        for (unsigned j = 0; j < 16; ++j) { const unsigned c = xb_ld(&bar[XB_XCNT(j)]); sum += c; cnt += (c > 0u) ? 1u : 0u; mine = (j == x) ? c : mine; }
        if (sum == G) break;
        __builtin_amdgcn_s_sleep(1);
        if ((++sp & 255u) == 0u) { if (xb_ld(&bar[XB_TMO])) break; if (sp > XB_SPIN_CAP) { atomicAdd(&bar[XB_TMO], 1u); break; } }
    }
    nloc = mine > 0u ? mine : 1u; nx = cnt > 0u ? cnt : 1u;
}
__device__ __forceinline__ void xcd_barrier(const XcdBarrier& b) {
    asm volatile("s_waitcnt vmcnt(0)" ::: "memory");
    __syncthreads();
    if (threadIdx.x == 0) {
        unsigned* bar = b.bar;
        __builtin_amdgcn_s_waitcnt(0);
        unsigned nloc = b.st[0], nx = b.st[1];
        if (nloc == 0u) { xcd_barrier_complete(bar, b.x, nloc, nx); b.st[0] = nloc; b.st[1] = nx; }
        const unsigned old = xb_add(&bar[XB_XSUB(b.x)], 1u);
        const unsigned gen = old / nloc;
        if (old + 1u == (gen + 1u) * nloc) {
            __builtin_amdgcn_fence(__ATOMIC_RELEASE, "agent");
            asm volatile("s_waitcnt vmcnt(0)" ::: "memory");
            const unsigned og = xb_add(&bar[XB_TOP], 1u);
            const unsigned tg = og / nx;
            if (og + 1u == (tg + 1u) * nx) xb_add(&bar[XB_TOPGEN], 1u);
            else XB_SPIN(xb_ld(&bar[XB_TOPGEN]) == tg, bar);
            __builtin_amdgcn_fence(__ATOMIC_ACQUIRE, "agent");
            xb_add(&bar[XB_XGEN(b.x)], 1u);
            asm volatile("s_waitcnt vmcnt(0)" ::: "memory");
        } else {
            XB_SPIN(xb_ld(&bar[XB_XGEN(b.x)]) == gen, bar);
            __builtin_amdgcn_fence(__ATOMIC_ACQUIRE, "agent");
            asm volatile("s_waitcnt vmcnt(0)" ::: "memory");
        }
    }
    __syncthreads();
}

constexpr size_t WS_SSQ1 = 0, WS_SSQ2 = 98304, WS_SSQ3 = 196608, WS_BAR = 294912, WS_COLMAX = 308736, WS_COLMAX1 = 343552, WS_SWINV = 387584, WS_FR = 422400, WS_RSQ = 520704, CTL_BYTES = 1u << 20;
constexpr size_t WS_W1A = CTL_BYTES;
constexpr size_t WS_W1B = WS_W1A + (size_t)2 * FF * DM * 2;
constexpr size_t WS_WIN = WS_W1B + (size_t)DM * FF * 2;
constexpr size_t WS_WA = WS_WIN + (size_t)NIN * DM * 2;
constexpr size_t WS_WB = WS_WA + (size_t)DM * 1024 * 2;
constexpr size_t WS_WOUT = WS_WB + (size_t)DM * 1024 * 2;
constexpr size_t WS_HB = WS_WOUT + (size_t)DM * DM * 2;
constexpr size_t WS_R1 = WS_HB + (size_t)M * DM * 2;
constexpr size_t WS_YAB = WS_R1 + (size_t)M * NQKV * 2;
constexpr size_t WS_END = WS_YAB + (size_t)M * DM * 2;
static_assert(WS_R1 + (size_t)M * FF * 2 <= WS_END, "ACT fits");

constexpr int LDS_BYTES = 147456;
constexpr int N_PHASES = 14;

struct Args { const float* in[18]; float* out; unsigned char* ws; int ph_lo, ph_hi; };

template <int MODE>
__device__ __forceinline__ void transpose_item(const float* W, int K, int N, bf16_t* WT, const float* gain, LAS float* scr, int item, int lane) {
    const int nblk = N / 32, kb = item / nblk, nb = item % nblk, k0 = 64 * kb, n0 = 32 * nb;
    int d0 = n0;
    if (MODE == 1) { const int up = n0 >= FF, j = up ? n0 - FF : n0; d0 = (j >> 7) * 256 + up * 128 + (j & 127); }
#pragma unroll
    for (int i = 0; i < 32; ++i) { const int kk = 2 * i + (lane >> 5); float v = W[(size_t)(k0 + kk) * N + n0 + (lane & 31)]; if (gain) v *= gain[k0 + kk]; scr[kk * 33 + (lane & 31)] = v; }
    asm volatile("s_waitcnt lgkmcnt(0)" ::: "memory");
    const int c = lane & 7;
#pragma unroll
    for (int j = 0; j < 4; ++j) { const int n = (lane >> 3) + 8 * j; const LAS float* s = scr + (8 * c) * 33 + n;
        u32x4 o; o.x = cvt_pk_bf16(s[0 * 33], s[1 * 33]); o.y = cvt_pk_bf16(s[2 * 33], s[3 * 33]); o.z = cvt_pk_bf16(s[4 * 33], s[5 * 33]); o.w = cvt_pk_bf16(s[6 * 33], s[7 * 33]);
        *(u32x4*)(WT + (size_t)(d0 + n) * K + k0 + 8 * c) = o; }
    asm volatile("s_waitcnt lgkmcnt(0)" ::: "memory");
}

template <int MODE> __device__ __forceinline__ void quant_item(const float* W, int K, int N, unsigned char* W8, const float* gain, const float* colmax, float* swinv, LAS float* scr, int item, int lane) {
    const int nblk = N / 32, kb = item / nblk, nb = item % nblk, k0 = 64 * kb, n0 = 32 * nb;
    int d0 = n0;
    if (MODE == 1) { const int up = n0 >= FF, jj = up ? n0 - FF : n0; d0 = (jj >> 7) * 256 + up * 128 + (jj & 127); }
#pragma unroll
    for (int i = 0; i < 32; ++i) { const int kk = 2 * i + (lane >> 5); scr[kk * 33 + (lane & 31)] = W[(size_t)(k0 + kk) * N + n0 + (lane & 31)] * gain[k0 + kk]; }
    asm volatile("s_waitcnt lgkmcnt(0)" ::: "memory");
    const int c = lane & 7;
#pragma unroll
    for (int j = 0; j < 4; ++j) { const int n = (lane >> 3) + 8 * j; const LAS float* sp = scr + (8 * c) * 33 + n;
        const float cm = ld_agent(colmax + n0 + n), sc = cm > 0.f ? 127.f / cm : 0.f;
        unsigned w0 = 0u, w1 = 0u;
#pragma unroll
        for (int e = 0; e < 4; ++e) { int q0 = (int)rintf(sp[e * 33] * sc), q1 = (int)rintf(sp[(e + 4) * 33] * sc);
            q0 = q0 < -127 ? -127 : (q0 > 127 ? 127 : q0); q1 = q1 < -127 ? -127 : (q1 > 127 ? 127 : q1);
            w0 |= ((unsigned)q0 & 0xffu) << (8 * e); w1 |= ((unsigned)q1 & 0xffu) << (8 * e); }
        u32x2 o; o.x = w0; o.y = w1;
        *(u32x2*)(W8 + (size_t)(d0 + n) * K + k0 + 8 * c) = o;
        if (kb == 0 && c == 0) swinv[d0 + n] = cm * (1.f / 127.f); }
    asm volatile("s_waitcnt lgkmcnt(0)" ::: "memory");
}

template <int MODE, bool GAIN>
__device__ __forceinline__ void item_loads(const float* W, int N, const float* gain, int item, int lane, float (&r)[32]) {
    const int nblk = N / 32, kb = item / nblk, nb = item % nblk, k0 = 64 * kb, n0 = 32 * nb;
#pragma unroll
    for (int i = 0; i < 32; ++i) { const int kk = 2 * i + (lane >> 5); float v = W[(size_t)(k0 + kk) * N + n0 + (lane & 31)]; if (GAIN) v *= gain[k0 + kk]; r[i] = v; }
}
template <int MODE, bool GAIN>
__device__ __forceinline__ void transpose_loop2(const float* W, int K, int N, bf16_t* WT, const float* gain, LAS float* scr, int first, int n, int stride, int lane);
template <int MODE, bool GAIN>
__device__ __forceinline__ void quant_loop2(const float* W, int K, int N, unsigned char* W8, const float* gain, const float* colmax, float* swinv, LAS float* scr, int first, int n, int stride, int lane);
__device__ __forceinline__ int item_d0(int n0, int mode) { if (mode != 1) return n0; const int up = n0 >= FF, jj = up ? n0 - FF : n0; return (jj >> 7) * 256 + up * 128 + (jj & 127); }
template <int MODE>
__device__ __forceinline__ void transpose_finish(const float (&r)[32], int K, int N, bf16_t* WT, LAS float* scr, int item, int lane) {
    const int nblk = N / 32, kb = item / nblk, nb = item % nblk, k0 = 64 * kb, d0 = item_d0(32 * nb, MODE);
#pragma unroll
    for (int i = 0; i < 32; ++i) { const int kk = 2 * i + (lane >> 5); scr[kk * 33 + (lane & 31)] = r[i]; }
    asm volatile("s_waitcnt lgkmcnt(0)" ::: "memory");
    const int c = lane & 7;
#pragma unroll
    for (int j = 0; j < 4; ++j) { const int n = (lane >> 3) + 8 * j; const LAS float* sp = scr + (8 * c) * 33 + n;
        u32x4 o; o.x = cvt_pk_bf16(sp[0 * 33], sp[1 * 33]); o.y = cvt_pk_bf16(sp[2 * 33], sp[3 * 33]); o.z = cvt_pk_bf16(sp[4 * 33], sp[5 * 33]); o.w = cvt_pk_bf16(sp[6 * 33], sp[7 * 33]);
        *(u32x4*)(WT + (size_t)(d0 + n) * K + k0 + 8 * c) = o; }
    asm volatile("s_waitcnt lgkmcnt(0)" ::: "memory");
}
template <int MODE>
__device__ __forceinline__ void quant_finish(const float (&r)[32], int K, int N, unsigned char* W8, const float* colmax, float* swinv, LAS float* scr, int item, int lane) {
    const int nblk = N / 32, kb = item / nblk, nb = item % nblk, k0 = 64 * kb, n0 = 32 * nb, d0 = item_d0(n0, MODE);
#pragma unroll
    for (int i = 0; i < 32; ++i) { const int kk = 2 * i + (lane >> 5); scr[kk * 33 + (lane & 31)] = r[i]; }
    asm volatile("s_waitcnt lgkmcnt(0)" ::: "memory");
    const int c = lane & 7;
#pragma unroll
    for (int j = 0; j < 4; ++j) { const int n = (lane >> 3) + 8 * j; const LAS float* sp = scr + (8 * c) * 33 + n;
        const float cm = ld_agent(colmax + n0 + n), sc = cm > 0.f ? 127.f / cm : 0.f;
        unsigned w0 = 0u, w1 = 0u;
#pragma unroll
        for (int e = 0; e < 4; ++e) { int q0 = (int)rintf(sp[e * 33] * sc), q1 = (int)rintf(sp[(e + 4) * 33] * sc);
            q0 = q0 < -127 ? -127 : (q0 > 127 ? 127 : q0); q1 = q1 < -127 ? -127 : (q1 > 127 ? 127 : q1);
            w0 |= ((unsigned)q0 & 0xffu) << (8 * e); w1 |= ((unsigned)q1 & 0xffu) << (8 * e); }
        u32x2 o; o.x = w0; o.y = w1;
        *(u32x2*)(W8 + (size_t)(d0 + n) * K + k0 + 8 * c) = o;
        if (kb == 0 && c == 0) swinv[d0 + n] = cm * (1.f / 127.f); }
    asm volatile("s_waitcnt lgkmcnt(0)" ::: "memory");
}

template <int MODE, bool GAIN>
__device__ __forceinline__ void transpose_loop2(const float* W, int K, int N, bf16_t* WT, const float* gain, LAS float* scr, int first, int n, int stride, int lane) {
    for (int it = first; it < n; it += 2 * stride) { const int itB = it + stride; float ra[32], rb[32];
        item_loads<MODE, GAIN>(W, N, gain, it, lane, ra); if (itB < n) item_loads<MODE, GAIN>(W, N, gain, itB, lane, rb);
        transpose_finish<MODE>(ra, K, N, WT, scr, it, lane); if (itB < n) transpose_finish<MODE>(rb, K, N, WT, scr, itB, lane); }
}
template <int MODE, bool GAIN>
__device__ __forceinline__ void quant_loop2(const float* W, int K, int N, unsigned char* W8, const float* gain, const float* colmax, float* swinv, LAS float* scr, int first, int n, int stride, int lane) {
    for (int it = first; it < n; it += 2 * stride) { const int itB = it + stride; float ra[32], rb[32];
        item_loads<MODE, GAIN>(W, N, gain, it, lane, ra); if (itB < n) item_loads<MODE, GAIN>(W, N, gain, itB, lane, rb);
        quant_finish<MODE>(ra, K, N, W8, colmax, swinv, scr, it, lane); if (itB < n) quant_finish<MODE>(rb, K, N, W8, colmax, swinv, scr, itB, lane); }
}

__global__ void __launch_bounds__(512, 2) mk_fwd(Args args) {
    extern __shared__ __attribute__((aligned(16))) unsigned char lds[];
    LAS unsigned char* ldsl = (LAS unsigned char*)lds;
    const int tid = threadIdx.x, lane = tid & 63, wave = __builtin_amdgcn_readfirstlane(tid >> 6);
    const int G = gridDim.x, bx = blockIdx.x;
    const int gw = bx * 8 + wave, NGW = G * 8;
    unsigned char* ws = args.ws;
    const float* x_prompt = args.in[0]; const float* x_sample = args.in[1];
    float* ssq1 = (float*)(ws + WS_SSQ1); float* ssq2 = (float*)(ws + WS_SSQ2); float* ssq3 = (float*)(ws + WS_SSQ3); float* colmax = (float*)(ws + WS_COLMAX); float* swinv = (float*)(ws + WS_SWINV); float* frow = (float*)(ws + WS_FR);
    bf16_t* W1A = (bf16_t*)(ws + WS_W1A); bf16_t* W1B = (bf16_t*)(ws + WS_W1B); bf16_t* WIN = (bf16_t*)(ws + WS_WIN);
    bf16_t* WA = (bf16_t*)(ws + WS_WA); bf16_t* WB = (bf16_t*)(ws + WS_WB); bf16_t* WOUT = (bf16_t*)(ws + WS_WOUT);
    bf16_t* HB = (bf16_t*)(ws + WS_HB); bf16_t* ACT = (bf16_t*)(ws + WS_R1); bf16_t* QKV = (bf16_t*)(ws + WS_R1); bf16_t* GT = (bf16_t*)(ws + WS_R1);
    bf16_t* YAB = (bf16_t*)(ws + WS_YAB);
    float* out = args.out;
    const int lo = args.ph_lo, hi = args.ph_hi;
    volatile LAS unsigned* bst = (volatile LAS unsigned*)(ldsl + 140288);
    if (tid < 2) bst[tid] = 0u;
    __syncthreads();
    const XcdBarrier xbar = xcd_barrier_post((unsigned*)(ws + WS_BAR), bst);
#ifndef PH_MASK
#define PH_MASK 0xffff
#endif
#define IN(k) (((PH_MASK >> (k)) & 1) && lo <= (k) && (k) < hi)
#if MK_PER_PHASE
#define SEAM(k) do { } while (0)
#else
#define SEAM(k) do { if (IN(k) && IN((k) + 1)) { if ((k) == 0) cg::this_grid().sync(); else xcd_barrier(xbar); } } while (0)
#endif

    if (IN(0)) {
        LAS float* scr = (LAS float*)(ldsl + wave * 16384);
        constexpr int I_1A = (DM / 64) * (2 * FF / 32);
        {
            const float* Win = args.in[6]; const float* gm = args.in[5];
            for (int t = bx * 512 + tid; t < 64 * NIN; t += G * 512) {
                const int ch = t / NIN, n = t - ch * NIN; float mx = 0.f;
#pragma unroll
                for (int k = ch * 32; k < ch * 32 + 32; ++k) mx = fmaxf(mx, fabsf(Win[(size_t)k * NIN + n] * gm[k]));
                atomicMax((int*)colmax + n, __float_as_int(mx));
            }
        }
        float* colmax1 = (float*)(ws + WS_COLMAX1); float* swinv1 = (float*)(ws + 650240); float* frow1 = (float*)(ws + 700416);
        {
            const float* W1 = args.in[3]; const float* g1 = args.in[2];
            for (int t = bx * 512 + tid; t < 64 * 2 * FF; t += G * 512) {
                const int ch = t / (2 * FF), n = t - ch * (2 * FF); float mx = 0.f;
#pragma unroll
                for (int k = ch * 32; k < ch * 32 + 32; ++k) mx = fmaxf(mx, fabsf(W1[(size_t)k * (2 * FF) + n] * g1[k]));
                atomicMax((int*)colmax1 + n, __float_as_int(mx));
            }
        }
        for (int m0 = gw; m0 < M; m0 += 4 * NGW) {
            f32x4 v[4][8]; int mm[4];
#pragma unroll
            for (int rr = 0; rr < 4; ++rr) { mm[rr] = (m0 + rr * NGW < M) ? m0 + rr * NGW : m0;
                const float* xr = (mm[rr] < MP) ? x_prompt + (size_t)mm[rr] * DM : x_sample + (size_t)(mm[rr] - MP) * DM;
                const f32x4* x4 = (const f32x4*)xr + lane;
#pragma unroll
                for (int j = 0; j < 8; ++j) v[rr][j] = x4[64 * j]; }
#pragma unroll
            for (int rr = 0; rr < 4; ++rr) {
                float s = 0.f, mx = 0.f;
#pragma unroll
                for (int j = 0; j < 8; ++j) { s += (v[rr][j][0] * v[rr][j][0] + v[rr][j][1] * v[rr][j][1]) + (v[rr][j][2] * v[rr][j][2] + v[rr][j][3] * v[rr][j][3]);
                    mx = fmaxf(mx, fmaxf(fmaxf(fabsf(v[rr][j][0]), fabsf(v[rr][j][1])), fmaxf(fabsf(v[rr][j][2]), fabsf(v[rr][j][3])))); }
                s = wave_sum(s);
#pragma unroll
                for (int o = 1; o < 64; o <<= 1) mx = fmaxf(mx, __shfl_xor(mx, o));
                const float sc = mx > 0.f ? 127.f / mx : 0.f;
                unsigned* o4 = (unsigned*)((unsigned char*)HB + (size_t)mm[rr] * DM) + lane;
#pragma unroll
                for (int j = 0; j < 8; ++j) { unsigned w = 0u;
#pragma unroll
                    for (int e = 0; e < 4; ++e) w |= ((unsigned)(int)rintf(v[rr][j][e] * sc) & 0xffu) << (8 * e);
                    o4[64 * j] = w; }
                if (lane == 0) frow1[mm[rr]] = __builtin_amdgcn_rsqf(s * (1.f / 2048.f) + EPS) * mx * (1.f / 127.f);
            }
        }
        xcd_barrier(xbar);
        for (int it = gw; it < I_1A; it += 4 * NGW) {
            float r0[32], r1[32], r2[32], r3[32]; const int i1 = it + NGW, i2 = it + 2 * NGW, i3 = it + 3 * NGW;
            item_loads<1, true>(args.in[3], 2 * FF, args.in[2], it, lane, r0);
            if (i1 < I_1A) item_loads<1, true>(args.in[3], 2 * FF, args.in[2], i1, lane, r1);
            if (i2 < I_1A) item_loads<1, true>(args.in[3], 2 * FF, args.in[2], i2, lane, r2);
            if (i3 < I_1A) item_loads<1, true>(args.in[3], 2 * FF, args.in[2], i3, lane, r3);
            quant_finish<1>(r0, DM, 2 * FF, (unsigned char*)W1A, colmax1, swinv1, scr, it, lane);
            if (i1 < I_1A) quant_finish<1>(r1, DM, 2 * FF, (unsigned char*)W1A, colmax1, swinv1, scr, i1, lane);
            if (i2 < I_1A) quant_finish<1>(r2, DM, 2 * FF, (unsigned char*)W1A, colmax1, swinv1, scr, i2, lane);
            if (i3 < I_1A) quant_finish<1>(r3, DM, 2 * FF, (unsigned char*)W1A, colmax1, swinv1, scr, i3, lane);
        }
        __syncthreads();
    }
    SEAM(0);
    if (IN(1)) {
        pg8::Gemm g{HB, W1A, M, 2 * FF, DM / 2, DM / 2, DM / 2}; pg8::StaticOrder S; S.init(M, 2 * FF, G, bx);
        pg8::EpiSwiglu8 E{ACT, (const float*)(ws + 700416), (const float*)(ws + 650240)};
        pg8::gemm_phase(ldsl, g, S, E);
        {
            constexpr int NU = (M / 256) * (2 * FF / 256);
            const int rounds = (NU + G - 1) / G, n_full = NU - (rounds - 1) * G;
            const int nh = (n_full < G) ? G - n_full : G, hidx = (n_full < G) ? bx - n_full : bx;
            if (hidx >= 0) {
                LAS float* scr = (LAS float*)(ldsl + wave * 16384);
                constexpr int I_1B = (FF / 64) * (DM / 32), I_IN = (DM / 64) * (NIN / 32), I_A = (1024 / 64) * (DM / 32), I_O = (DM / 64) * (DM / 32);
                constexpr int NLATE = I_1B + I_IN + 2 * I_A + I_O;
                const int first = hidx * 8 + wave, stride = nh * 8;
                transpose_loop2<0, false>(args.in[4], FF, DM, W1B, nullptr, scr, first, I_1B, stride, lane);
                quant_loop2<0, true>(args.in[6], DM, NIN, (unsigned char*)WIN, args.in[5], colmax, swinv, scr, first, I_IN, stride, lane);
                transpose_loop2<0, false>(args.in[11], 1024, DM, WA, nullptr, scr, first, I_A, stride, lane);
                transpose_loop2<0, false>(args.in[12], 1024, DM, WB, nullptr, scr, first, I_A, stride, lane);
                transpose_loop2<0, false>(args.in[13], DM, DM, WOUT, nullptr, scr, first, I_O, stride, lane);
            }
            __syncthreads();
        }
    }
    SEAM(1);
    if (IN(2)) {
        pg8::Gemm g{ACT, W1B, M, DM, FF, FF, FF}; pg8::StaticOrder S; S.init(M, DM, G, bx);
        pg8::EpiResid<true, false> E{x_prompt, x_sample, out, HB, nullptr, 0.5f};
        pg8::gemm_phase(ldsl, g, S, E);
    }
    SEAM(2);
    if (IN(3)) {
        for (int m0 = gw; m0 < M; m0 += 2 * NGW) {
            u32x4 v[2][4]; int mm[2];
#pragma unroll
            for (int rr = 0; rr < 2; ++rr) { mm[rr] = (m0 + rr * NGW < M) ? m0 + rr * NGW : m0; const u32x4* row = (const u32x4*)(HB + (size_t)mm[rr] * DM);
#pragma unroll
                for (int j = 0; j < 4; ++j) v[rr][j] = row[lane + 64 * j]; }
            asm volatile("" ::: "memory");
#pragma unroll
            for (int rr = 0; rr < 2; ++rr) {
                float ss = 0.f, mx = 0.f;
#pragma unroll
                for (int j = 0; j < 4; ++j)
#pragma unroll
                    for (int e = 0; e < 4; ++e) { const float a = bf_lo(v[rr][j][e]), c = bf_hi(v[rr][j][e]); ss += a * a + c * c; mx = fmaxf(mx, fmaxf(fabsf(a), fabsf(c))); }
                ss = wave_sum(ss);
#pragma unroll
                for (int o = 1; o < 64; o <<= 1) mx = fmaxf(mx, __shfl_xor(mx, o));
                const float sc = mx > 0.f ? 127.f / mx : 0.f;
                if (rr == 1 && mm[1] == mm[0]) continue;
                u32x2* o8 = (u32x2*)(HB + (size_t)mm[rr] * DM);
#pragma unroll
                for (int j = 0; j < 4; ++j) { unsigned w[2] = {0u, 0u};
#pragma unroll
                    for (int e = 0; e < 4; ++e) { const int q0 = (int)rintf(bf_lo(v[rr][j][e]) * sc), q1 = (int)rintf(bf_hi(v[rr][j][e]) * sc);
                        w[e >> 1] |= (((unsigned)q0 & 0xffu) | (((unsigned)q1 & 0xffu) << 8)) << (16 * (e & 1)); }
                    u32x2 o; o.x = w[0]; o.y = w[1]; o8[lane + 64 * j] = o; }
                if (lane == 0) { const float f = __builtin_amdgcn_rsqf(ss * (1.f / 2048.f) + EPS) * mx * (1.f / 127.f); frow[mm[rr]] = f;
                    ((float*)(ws + WS_RSQ))[mm[rr]] = f > 0.f ? 2048.f / (f * f) - 2048.f * EPS : 0.f; }
            }
        }
        __syncthreads();
    }
    SEAM(3);
    if (IN(4)) {
        pg8::Gemm g{HB, WIN, M, NQKV, DM / 2, DM, DM / 2}; pg8::StaticOrder S; S.init(M, NQKV, G, bx);
        pg8::EpiScaled8<0> E{QKV, NQKV, frow, swinv, nullptr};
        pg8::gemm_phase(ldsl, g, S, E);
    }
    SEAM(4);
    if (IN(5)) {
        const float* gq = args.in[8]; const float* gk = args.in[9];
        const float gq0 = gq[2 * lane], gq1 = gq[2 * lane + 1], gk0 = gk[2 * lane], gk1 = gk[2 * lane + 1];
        const float inv = __builtin_amdgcn_exp2f(-(float)(lane & 31) * (13.287712379549449f / 32.f)) * 0.15915494309189535f;
        for (int m = gw; m < M; m += NGW) {
            const int t = (m < MP) ? (m & 4095) : ((m - MP) & 2047);
            const float pos = (lane < 32) ? (float)(t >> 6) : (float)(t & 63);
            const float rev = __builtin_amdgcn_fractf(pos * inv);
            const float sn = __builtin_amdgcn_sinf(rev), cn = __builtin_amdgcn_cosf(rev);
            bf16_t* row = QKV + (size_t)m * NQKV;
#pragma unroll
            for (int hh = 0; hh < 10; ++hh) {
                unsigned* p = (unsigned*)(row + hh * 128) + lane;
                const unsigned w = *p; const float x0 = bf_lo(w), x1 = bf_hi(w);
                const float rn = __builtin_amdgcn_rsqf(wave_sum(x0 * x0 + x1 * x1) * (1.f / 128.f) + EPS);
                const float y0 = x0 * rn * (hh < 8 ? gq0 : gk0), y1 = x1 * rn * (hh < 8 ? gq1 : gk1);
                *p = cvt_pk_bf16(y0 * cn - y1 * sn, y0 * sn + y1 * cn);
            }
        }
        LAS float* scr = (LAS float*)(ldsl + wave * 16384);
        constexpr int I_1A = (DM / 64) * (2 * FF / 32), I_1B = (FF / 64) * (DM / 32);
        for (int it = gw; it < I_1A; it += 4 * NGW) {
            float r0[32], r1[32], r2[32], r3[32]; const int i1 = it + NGW, i2 = it + 2 * NGW, i3 = it + 3 * NGW;
            item_loads<1, true>(args.in[15], 2 * FF, args.in[14], it, lane, r0);
            if (i1 < I_1A) item_loads<1, true>(args.in[15], 2 * FF, args.in[14], i1, lane, r1);
            if (i2 < I_1A) item_loads<1, true>(args.in[15], 2 * FF, args.in[14], i2, lane, r2);
            if (i3 < I_1A) item_loads<1, true>(args.in[15], 2 * FF, args.in[14], i3, lane, r3);
            transpose_finish<1>(r0, DM, 2 * FF, W1A, scr, it, lane);
            if (i1 < I_1A) transpose_finish<1>(r1, DM, 2 * FF, W1A, scr, i1, lane);
            if (i2 < I_1A) transpose_finish<1>(r2, DM, 2 * FF, W1A, scr, i2, lane);
            if (i3 < I_1A) transpose_finish<1>(r3, DM, 2 * FF, W1A, scr, i3, lane);
        }
        transpose_loop2<0, false>(args.in[16], FF, DM, W1B, nullptr, scr, gw, I_1B, NGW, lane);
        __syncthreads();
    }
    SEAM(5);
    if (IN(6)) {
        for (int vc = bx; vc < 256; vc += G) {
            const int xcd = vc & 7, slot = vc >> 3;
#ifndef NO_DENSE
            for (int j = 0; j < 3; ++j) {
                int b, kvh, hq, qb, seq; size_t tb;
                if (j == 0) { const int combo = xcd >> 1, idx = (xcd & 1) * 32 + slot; b = combo >> 1; kvh = combo & 1; hq = kvh * 4 + (idx >> 4); qb = idx & 15; tb = (size_t)b * 4096; seq = 4096; }
                else { const int combo = xcd * 2 + j - 1; b = combo >> 1; kvh = combo & 1; hq = kvh * 4 + (slot >> 3); qb = slot & 7; tb = (size_t)MP + (size_t)b * 2048; seq = 2048; }
                __syncthreads();
                att::attn_dense_body(QKV + (tb + qb * 256) * NQKV + hq * 128, QKV + tb * NQKV + 1024 + kvh * 128, QKV + tb * NQKV + 1280 + kvh * 128,
                                     YAB + (tb + qb * 256) * DM + hq * 128, seq, (char*)lds);
            }
#endif
#ifndef NO_NA
            for (int j = 0; j < 3; ++j) {
                const int u = vc + 256 * j, h = u & 7, rb = u >> 3;
                att::na_unit(QKV, YAB, args.in[10], rb, h, (char*)lds);
            }
#endif
        }
        __syncthreads();
    }
    SEAM(6);
    if (IN(7)) {
        pg8::Gemm g{HB, WIN + (size_t)NQKV * (DM / 2), M, NGATE, DM / 2, DM, DM / 2}; pg8::StaticOrder S; S.init(M, NGATE, G, bx);
        pg8::EpiGates8 E{GT, NGATE, (const float*)(ws + WS_RSQ), args.in[7], swinv + NQKV};
        pg8::gemm_phase(ldsl, g, S, E);
    }
    SEAM(7);
    if (IN(8)) {
        pg8::Gemm g{YAB, WA, M, DM, 1024, DM, 1024}; pg8::StaticOrder S; S.init(M, DM, G, bx);
        pg8::EpiMerge<0> E{GT};
        pg8::gemm_phase(ldsl, g, S, E);
    }
    if (IN(9)) {
        pg8::Gemm g{YAB + 1024, WB, M, DM, 1024, DM, 1024}; pg8::StaticOrder S; S.init(M, DM, G, bx);
        pg8::EpiMerge<1> E{GT};
        pg8::gemm_phase(ldsl, g, S, E);
    }
    SEAM(9);
    if (IN(10)) {
        pg8::Gemm g{GT, WOUT, M, DM, DM, NGATE, DM}; pg8::StaticOrder S; S.init(M, DM, G, bx);
        pg8::EpiResid<true, true> E{out, out + (size_t)MP * DM, out, HB, ssq3, 1.0f};
        pg8::gemm_phase(ldsl, g, S, E);
    }
    SEAM(10);
    if (IN(11)) {
        pg8::Gemm g{HB, W1A, M, 2 * FF, DM, DM, DM}; pg8::StaticOrder S; S.init(M, 2 * FF, G, bx);
        pg8::EpiSwiglu E{ACT, ssq3};
        pg8::gemm_phase(ldsl, g, S, E);
    }
    SEAM(11);
    if (IN(12)) {
        pg8::Gemm g{ACT, W1B, M, DM, FF, FF, FF}; pg8::StaticOrder S; S.init(M, DM, G, bx);
        pg8::EpiResid<false, false> E{out, out + (size_t)MP * DM, out, nullptr, nullptr, 0.5f};
        pg8::gemm_phase(ldsl, g, S, E);
    }
    SEAM(12);
    if (IN(13)) {
        const f32x4* g4 = (const f32x4*)args.in[17] + lane;
        for (int m0 = gw; m0 < M; m0 += 4 * NGW) {
            f32x4 v[4][8]; float s[4] = {0.f, 0.f, 0.f, 0.f}; f32x4* x4[4];
#pragma unroll
            for (int rr = 0; rr < 4; ++rr) { const int m = (m0 + rr * NGW < M) ? m0 + rr * NGW : m0;
                x4[rr] = (f32x4*)(out + (size_t)m * DM) + lane;
#pragma unroll
                for (int j = 0; j < 8; ++j) v[rr][j] = x4[rr][64 * j]; }
#pragma unroll
            for (int rr = 0; rr < 4; ++rr)
#pragma unroll
                for (int j = 0; j < 8; ++j) s[rr] += (v[rr][j][0] * v[rr][j][0] + v[rr][j][1] * v[rr][j][1]) + (v[rr][j][2] * v[rr][j][2] + v[rr][j][3] * v[rr][j][3]);
#pragma unroll
            for (int rr = 0; rr < 4; ++rr) { const float rs = __builtin_amdgcn_rsqf(wave_sum(s[rr]) * (1.f / 2048.f) + EPS);
#pragma unroll
                for (int j = 0; j < 8; ++j) x4[rr][64 * j] = v[rr][j] * rs * g4[64 * j]; }
        }
    }
#undef IN
#undef SEAM
}

extern "C" void kernel_launch(void* const* d_in, const int* in_sizes, int n_in, void* d_out, int out_size, void* d_ws, size_t ws_size, hipStream_t stream) {
    static int grid = 0;
    if (grid == 0) {
        if (n_in != 18 || in_sizes[0] != MP * DM || in_sizes[1] != (M - MP) * DM || out_size != M * DM || ws_size < WS_END) {
            fprintf(stderr, "kernel_launch: shape mismatch (n_in %d, in0 %d, in1 %d, out %d, ws %zu, need ws >= %zu); nothing launched\n", n_in, n_in > 0 ? in_sizes[0] : -1, n_in > 1 ? in_sizes[1] : -1, out_size, ws_size, (size_t)WS_END);
            grid = -1; return; }
        int dev = 0, cus = 0, per_cu = 0;
        if (hipGetDevice(&dev) != hipSuccess || hipDeviceGetAttribute(&cus, hipDeviceAttributeMultiprocessorCount, dev) != hipSuccess) { grid = -1; return; }
        if (hipFuncSetAttribute((const void*)mk_fwd, hipFuncAttributeMaxDynamicSharedMemorySize, LDS_BYTES) != hipSuccess) { fprintf(stderr, "kernel_launch: hipFuncSetAttribute failed\n"); grid = -1; return; }
        if (hipOccupancyMaxActiveBlocksPerMultiprocessor(&per_cu, (const void*)mk_fwd, 512, LDS_BYTES) != hipSuccess || per_cu < 1) { fprintf(stderr, "kernel_launch: occupancy query says %d\n", per_cu); per_cu = 1; }
        (void)hipGetLastError();
        grid = cus * (per_cu > 1 ? 1 : per_cu);
    }
    if (grid < 0) return;
    static_assert(WS_SSQ2 + 2 * 98304 == WS_BAR && WS_BAR + XCD_BAR_WORDS * 4 == WS_COLMAX && WS_COLMAX + NIN * 4 == WS_COLMAX1 && WS_COLMAX1 + 2 * FF * 4 == WS_SWINV, "one contiguous zeroed region");
    (void)hipMemsetAsync((char*)d_ws + WS_SSQ2, 0, WS_SWINV - WS_SSQ2, stream);
    Args a{};
    for (int i = 0; i < 18; ++i) a.in[i] = (const float*)d_in[i];
    a.out = (float*)d_out; a.ws = (unsigned char*)d_ws;
#if MK_PER_PHASE
    for (int p = 0; p < N_PHASES; ++p) { a.ph_lo = p; a.ph_hi = p + 1; hipLaunchKernelGGL(mk_fwd, dim3(grid), dim3(512), LDS_BYTES, stream, a); }
#else
    a.ph_lo = 0; a.ph_hi = N_PHASES;
    void* kargs[] = {&a};
    hipError_t e = hipLaunchCooperativeKernel((const void*)mk_fwd, dim3(grid), dim3(512), kargs, LDS_BYTES, stream);
    if (e != hipSuccess) fprintf(stderr, "kernel_launch: cooperative launch failed: %s (grid %d)\n", hipGetErrorString(e), grid);
#endif
}
```

```cpp
#include <hip/hip_runtime.h>
#include <hip/hip_cooperative_groups.h>
#include <cstdio>
#include <cstdint>
namespace cg = cooperative_groups;

#ifndef MK_PER_PHASE
#define MK_PER_PHASE 0
#endif

constexpr int M = 24576, MP = 8192, DM = 2048, FF = 5504, NQKV = 4608, NGATE = 4096, NIN = 8704;
constexpr float EPS = 1e-6f;
constexpr float LOG2E = 1.4426950408889634f;

#define LAS __attribute__((address_space(3)))
typedef unsigned short bf16_t;
typedef short bf16x8 __attribute__((ext_vector_type(8)));
typedef short s16x4 __attribute__((ext_vector_type(4)));
typedef float f32x4 __attribute__((ext_vector_type(4)));
typedef float f32x16 __attribute__((ext_vector_type(16)));
typedef unsigned u32x4 __attribute__((ext_vector_type(4)));
typedef unsigned u32x2 __attribute__((ext_vector_type(2)));
typedef int i32x4 __attribute__((ext_vector_type(4)));

__device__ __forceinline__ unsigned cvt_pk_bf16(float lo, float hi) { unsigned r; asm volatile("v_cvt_pk_bf16_f32 %0, %1, %2" : "=v"(r) : "v"(lo), "v"(hi)); return r; }
__device__ __forceinline__ float bf_lo(unsigned w) { return __uint_as_float(w << 16); }
__device__ __forceinline__ float bf_hi(unsigned w) { return __uint_as_float(w & 0xffff0000u); }
__device__ __forceinline__ float ld_agent(const float* p) { return __hip_atomic_load(p, __ATOMIC_RELAXED, __HIP_MEMORY_SCOPE_AGENT); }
__device__ __forceinline__ float rs_of(const float* ssq, int r) { return __builtin_amdgcn_rsqf(ld_agent(ssq + r) * (1.f / 2048.f) + EPS); }
__device__ __forceinline__ float sigm(float x) { return __builtin_amdgcn_rcpf(1.f + __builtin_amdgcn_exp2f(-LOG2E * x)); }
__device__ __forceinline__ float wave_sum(float v) {
#pragma unroll
    for (int o = 1; o < 64; o <<= 1) v += __shfl_xor(v, o);
    return v;
}

namespace pg8 {
constexpr int BM = 256, BK = 64, HALF = 128, HTB = HALF * BK * 2, STAGE_BYTES = 8 * HTB, NXCD = 8, WGM = 8;
__device__ __forceinline__ int lds_byte(int r, int c) { const int st = (r >> 4) * 2 + (c >> 5), rr = r & 15, cc = c & 31, ob = rr * 64 + cc * 2; return st * 1024 + (ob ^ (((ob >> 9) & 1) << 5)); }
__device__ __forceinline__ void stage_rc(int b, int& R, int& C) { const int st = b / 1024, sb = b % 1024, swz = sb ^ (((sb >> 9) & 1) << 5); R = (st >> 1) * 16 + swz / 64; C = (st & 1) * 32 + (swz % 64) / 2; }
__device__ __forceinline__ int perm32(int rho) { const int n = rho >> 4, i = rho & 15; return 8 * (i >> 2) + 4 * n + (i & 3); }

struct Unit { int pm, pn; };
struct Gemm { const bf16_t* A; const bf16_t* Bt; int M, N, K, lda, ldb; };

struct StaticOrder {
    int nM, nN, nwg, G, c;
    __device__ void init(int M_, int N_, int G_, int c_) { nM = M_ / BM; nN = N_ / BM; nwg = nM * nN; G = G_; c = c_; }
    __device__ bool next(int i, Unit& u) const {
        const long L = (long)i * G + c; if (L >= nwg) return false;
        int wgid = (int)L; { const int q = nwg / NXCD, r = nwg % NXCD, xcd = wgid % NXCD, off = wgid / NXCD; wgid = (xcd < r ? xcd * (q + 1) : r * (q + 1) + (xcd - r) * q) + off; }
        const int nig = WGM * nN, gid = wgid / nig, fm = gid * WGM, gsz = (nM - fm) < WGM ? (nM - fm) : WGM;
        u.pm = fm + ((wgid % nig) % gsz); u.pn = (wgid % nig) / gsz; return true;
    }
};

struct EpiSwiglu {
    static constexpr bool PERM = true, I8 = false; typedef f32x4 acc_t;
    bf16_t* O; const float* ssq;
    __device__ __forceinline__ void operator()(const f32x4 (&acc)[2][2][4][2], const Unit& u, int wr, int wc, int fr, int fq) const {
        const int row0 = u.pm * BM + wr * 64 + fr, col0 = u.pn * HALF + wc * 32 + 8 * fq;
        float sq[8];
#pragma unroll
        for (int g = 0; g < 8; ++g) sq[g] = ld_agent(ssq + row0 + (g >> 2) * HALF + (g & 3) * 16);
#pragma unroll
        for (int ai = 0; ai < 2; ++ai)
#pragma unroll
            for (int m = 0; m < 4; ++m) {
                const int r = row0 + ai * HALF + m * 16; const float rs = __builtin_amdgcn_rsqf(sq[ai * 4 + m] * (1.f / 2048.f) + EPS);
                float v[8];
#pragma unroll
                for (int n = 0; n < 2; ++n)
#pragma unroll
                    for (int j = 0; j < 4; ++j) { const float g = acc[ai][0][m][n][j] * rs, up = acc[ai][1][m][n][j] * rs; v[n * 4 + j] = g * sigm(g) * up; }
                u32x4 w; w.x = cvt_pk_bf16(v[0], v[1]); w.y = cvt_pk_bf16(v[2], v[3]); w.z = cvt_pk_bf16(v[4], v[5]); w.w = cvt_pk_bf16(v[6], v[7]);
                *(u32x4*)(O + (size_t)r * FF + col0) = w;
            }
    }
};
struct EpiSwiglu8 {
    static constexpr bool PERM = true, I8 = true; typedef i32x4 acc_t;
    bf16_t* O; const float* frs; const float* swinv;
    __device__ __forceinline__ void operator()(const i32x4 (&acc)[2][2][4][2], const Unit& u, int wr, int wc, int fr, int fq) const {
        const int row0 = u.pm * BM + wr * 64 + fr, col0 = u.pn * HALF + wc * 32 + 8 * fq, scol = u.pn * BM + wc * 32 + 8 * fq;
        float sq[8];
#pragma unroll
        for (int g = 0; g < 8; ++g) sq[g] = ld_agent(frs + row0 + (g >> 2) * HALF + (g & 3) * 16);
        f32x4 sg[2], su[2];
#pragma unroll
        for (int n = 0; n < 2; ++n) { sg[n] = *(const f32x4*)(swinv + scol + 4 * n); su[n] = *(const f32x4*)(swinv + scol + HALF + 4 * n); }
#pragma unroll
        for (int ai = 0; ai < 2; ++ai)
#pragma unroll
            for (int m = 0; m < 4; ++m) {
                const int r = row0 + ai * HALF + m * 16; const float rs = sq[ai * 4 + m];
                float v[8];
#pragma unroll
                for (int n = 0; n < 2; ++n)
#pragma unroll
                    for (int j = 0; j < 4; ++j) { const float g = (float)acc[ai][0][m][n][j] * rs * sg[n][j], up = (float)acc[ai][1][m][n][j] * rs * su[n][j]; v[n * 4 + j] = g * sigm(g) * up; }
                u32x4 w; w.x = cvt_pk_bf16(v[0], v[1]); w.y = cvt_pk_bf16(v[2], v[3]); w.z = cvt_pk_bf16(v[4], v[5]); w.w = cvt_pk_bf16(v[6], v[7]);
                *(u32x4*)(O + (size_t)r * FF + col0) = w;
            }
    }
};
template <int MODE> struct EpiScaled8 {
    static constexpr bool PERM = true, I8 = true; typedef i32x4 acc_t;
    bf16_t* O; int ldc; const float* fr; const float* swinv; const float* bias;
    __device__ __forceinline__ void operator()(const i32x4 (&acc)[2][2][4][2], const Unit& u, int wr, int wc, int fr_, int fq) const {
        const int row0 = u.pm * BM + wr * 64 + fr_, col0 = u.pn * BM + wc * 32 + 8 * fq;
        f32x4 sw[2][2], bv[2][2];
#pragma unroll
        for (int bj = 0; bj < 2; ++bj)
#pragma unroll
            for (int n = 0; n < 2; ++n) { sw[bj][n] = *(const f32x4*)(swinv + col0 + bj * HALF + 4 * n);
                bv[bj][n] = MODE == 1 ? *(const f32x4*)(bias + col0 + bj * HALF + 4 * n) : (f32x4){0.f, 0.f, 0.f, 0.f}; }
#pragma unroll
        for (int ai = 0; ai < 2; ++ai)
#pragma unroll
            for (int m = 0; m < 4; ++m) {
                asm volatile("" ::: "memory");
                const int r = row0 + ai * HALF + m * 16; const float rs = ld_agent(fr + r);
                bf16_t* rowp = O + (size_t)r * ldc + col0;
#pragma unroll
                for (int bj = 0; bj < 2; ++bj) {
                    f32x4 v0, v1;
#pragma unroll
                    for (int j = 0; j < 4; ++j) { v0[j] = (float)acc[ai][bj][m][0][j] * rs * sw[bj][0][j] + bv[bj][0][j]; v1[j] = (float)acc[ai][bj][m][1][j] * rs * sw[bj][1][j] + bv[bj][1][j]; }
                    if (MODE == 1) {
#pragma unroll
                        for (int j = 0; j < 4; ++j) { v0[j] = sigm(v0[j]); v1[j] = sigm(v1[j]); } }
                    u32x4 w; w.x = cvt_pk_bf16(v0[0], v0[1]); w.y = cvt_pk_bf16(v0[2], v0[3]); w.z = cvt_pk_bf16(v1[0], v1[1]); w.w = cvt_pk_bf16(v1[2], v1[3]);
                    *(u32x4*)(rowp + bj * HALF) = w;
                }
            }
    }
};
struct EpiGates8 {
    static constexpr bool PERM = true, I8 = true; typedef i32x4 acc_t;
    bf16_t* O; int ldc; const float* ssq; const float* bias; const float* swp;
    __device__ __forceinline__ void operator()(const i32x4 (&acc)[2][2][4][2], const Unit& u, int wr, int wc, int fr, int fq) const {
        const int row0 = u.pm * BM + wr * 64 + fr, col0 = u.pn * BM + wc * 32 + 8 * fq;
        f32x4 bv[2][2];
#pragma unroll
        for (int bj = 0; bj < 2; ++bj)
#pragma unroll
            for (int n = 0; n < 2; ++n) bv[bj][n] = *(const f32x4*)(bias + col0 + bj * HALF + 4 * n);
#pragma unroll
        for (int ai = 0; ai < 2; ++ai)
#pragma unroll
            for (int m = 0; m < 4; ++m) {
                const int r = row0 + ai * HALF + m * 16; const float rs = rs_of(ssq, r);
                bf16_t* rowp = O + (size_t)r * ldc + col0;
#pragma unroll
                for (int bj = 0; bj < 2; ++bj) {
                    const f32x4 s0 = *(const f32x4*)(swp + col0 + bj * HALF), s1 = *(const f32x4*)(swp + col0 + bj * HALF + 4);
                    f32x4 v0 = __builtin_convertvector(acc[ai][bj][m][0], f32x4) * s0 * rs + bv[bj][0], v1 = __builtin_convertvector(acc[ai][bj][m][1], f32x4) * s1 * rs + bv[bj][1];
#pragma unroll
                    for (int j = 0; j < 4; ++j) { v0[j] = sigm(v0[j]); v1[j] = sigm(v1[j]); }
                    u32x4 w; w.x = cvt_pk_bf16(v0[0], v0[1]); w.y = cvt_pk_bf16(v0[2], v0[3]); w.z = cvt_pk_bf16(v1[0], v1[1]); w.w = cvt_pk_bf16(v1[2], v1[3]);
                    *(u32x4*)(rowp + bj * HALF) = w;
                }
            }
    }
};
template <int STEP> struct EpiMerge {
    static constexpr bool PERM = true, I8 = false; typedef f32x4 acc_t;
    bf16_t* G;
    __device__ __forceinline__ void operator()(const f32x4 (&acc)[2][2][4][2], const Unit& u, int wr, int wc, int fr, int fq) const {
        const int row0 = u.pm * BM + wr * 64 + fr, col0 = u.pn * BM + wc * 32 + 8 * fq;
        bf16_t* base = G + (size_t)row0 * NGATE + col0;
        u32x4 ga[2], gb[2], na[2], nb[2];
#pragma unroll
        for (int bj = 0; bj < 2; ++bj) { ga[bj] = *(const u32x4*)(base + bj * HALF); if (STEP == 1) gb[bj] = *(const u32x4*)(base + bj * HALF + DM); }
#pragma unroll
        for (int g = 0; g < 8; ++g) {
            const int ai = g >> 2, m = g & 3;
            bf16_t* rowp = base + (size_t)(ai * HALF + m * 16) * NGATE;
            if (g < 7) { const bf16_t* nrow = base + (size_t)(((g + 1) >> 2) * HALF + ((g + 1) & 3) * 16) * NGATE;
#pragma unroll
                for (int bj = 0; bj < 2; ++bj) { na[bj] = *(const u32x4*)(nrow + bj * HALF); if (STEP == 1) nb[bj] = *(const u32x4*)(nrow + bj * HALF + DM); } }
#pragma unroll
            for (int bj = 0; bj < 2; ++bj) {
                const f32x4 a0 = acc[ai][bj][m][0], a1 = acc[ai][bj][m][1];
                float v[8];
                if (STEP == 0) {
                    v[0] = bf_lo(ga[bj].x) * a0[0]; v[1] = bf_hi(ga[bj].x) * a0[1]; v[2] = bf_lo(ga[bj].y) * a0[2]; v[3] = bf_hi(ga[bj].y) * a0[3];
                    v[4] = bf_lo(ga[bj].z) * a1[0]; v[5] = bf_hi(ga[bj].z) * a1[1]; v[6] = bf_lo(ga[bj].w) * a1[2]; v[7] = bf_hi(ga[bj].w) * a1[3];
                } else {
                    v[0] = bf_lo(ga[bj].x) + bf_lo(gb[bj].x) * a0[0]; v[1] = bf_hi(ga[bj].x) + bf_hi(gb[bj].x) * a0[1]; v[2] = bf_lo(ga[bj].y) + bf_lo(gb[bj].y) * a0[2]; v[3] = bf_hi(ga[bj].y) + bf_hi(gb[bj].y) * a0[3];
                    v[4] = bf_lo(ga[bj].z) + bf_lo(gb[bj].z) * a1[0]; v[5] = bf_hi(ga[bj].z) + bf_hi(gb[bj].z) * a1[1]; v[6] = bf_lo(ga[bj].w) + bf_lo(gb[bj].w) * a1[2]; v[7] = bf_hi(ga[bj].w) + bf_hi(gb[bj].w) * a1[3];
                }
                u32x4 w; w.x = cvt_pk_bf16(v[0], v[1]); w.y = cvt_pk_bf16(v[2], v[3]); w.z = cvt_pk_bf16(v[4], v[5]); w.w = cvt_pk_bf16(v[6], v[7]);
                *(u32x4*)(rowp + bj * HALF) = w;
            }
            asm volatile("" ::: "memory");
#pragma unroll
            for (int bj = 0; bj < 2; ++bj) { ga[bj] = na[bj]; if (STEP == 1) gb[bj] = nb[bj]; }
        }
    }
};
template <bool WITH_HB, bool WITH_SSQ> struct EpiResid {
    static constexpr bool PERM = false, I8 = false; typedef f32x4 acc_t;
    const float* base_lo; const float* base_hi; float* out; bf16_t* hb; float* ssq; float alpha;
    __device__ __forceinline__ void operator()(const f32x4 (&acc)[2][2][4][2], const Unit& u, int wr, int wc, int fr, int fq) const {
        const int row0 = u.pm * BM + wr * 64 + fr, col0 = u.pn * BM + wc * 32 + 4 * fq;
        const float* base = ((u.pm < MP / BM) ? base_lo : base_hi - (size_t)MP * DM) + (size_t)row0 * DM + col0;
        f32x4 b[2][2], nb[2][2];
#pragma unroll
        for (int bj = 0; bj < 2; ++bj)
#pragma unroll
            for (int n = 0; n < 2; ++n) b[bj][n] = *(const f32x4*)(base + bj * HALF + n * 16);
#pragma unroll
        for (int g = 0; g < 8; ++g) {
            const int ai = g >> 2, m = g & 3;
            const int r = row0 + ai * HALF + m * 16; const size_t off = (size_t)r * DM + col0; float s = 0.f;
            if (g < 7) { const float* nrow = base + (size_t)(((g + 1) >> 2) * HALF + ((g + 1) & 3) * 16) * DM;
#pragma unroll
                for (int bj = 0; bj < 2; ++bj)
#pragma unroll
                    for (int n = 0; n < 2; ++n) nb[bj][n] = *(const f32x4*)(nrow + bj * HALF + n * 16); }
#pragma unroll
            for (int bj = 0; bj < 2; ++bj)
#pragma unroll
                for (int n = 0; n < 2; ++n) {
                    const f32x4 o = b[bj][n] + acc[ai][bj][m][n] * alpha;
                    *(f32x4*)(out + off + bj * HALF + n * 16) = o;
                    if (WITH_SSQ) s += (o[0] * o[0] + o[1] * o[1]) + (o[2] * o[2] + o[3] * o[3]);
                    if (WITH_HB) { u32x2 w; w.x = cvt_pk_bf16(o[0], o[1]); w.y = cvt_pk_bf16(o[2], o[3]); *(u32x2*)(hb + off + bj * HALF + n * 16) = w; }
                }
            if (WITH_SSQ) { s += __shfl_xor(s, 16); s += __shfl_xor(s, 32); if (fq == 0) atomicAdd(ssq + r, s); }
            asm volatile("" ::: "memory");
#pragma unroll
            for (int bj = 0; bj < 2; ++bj)
#pragma unroll
                for (int n = 0; n < 2; ++n) b[bj][n] = nb[bj][n];
        }
    }
};

template <bool I8> struct MmaOp;
template <> struct MmaOp<false> { static __device__ __forceinline__ f32x4 run(bf16x8 a, bf16x8 b, f32x4 c) { return __builtin_amdgcn_mfma_f32_16x16x32_bf16(a, b, c, 0, 0, 0); } };
template <> struct MmaOp<true> { static __device__ __forceinline__ i32x4 run(bf16x8 a, bf16x8 b, i32x4 c) { return __builtin_amdgcn_mfma_i32_16x16x64_i8(__builtin_bit_cast(i32x4, a), __builtin_bit_cast(i32x4, b), c, 0, 0, 0); } };
template <class Epi, class Sched>
__device__ __forceinline__ void gemm_phase(LAS unsigned char* lds, const Gemm g, const Sched& S, const Epi& E) {
    const int tid = threadIdx.x, wid = __builtin_amdgcn_readfirstlane(tid >> 6), lane = tid & 63, wr = wid >> 2, wc = wid & 3, fr = lane & 15, fq = lane >> 4;
    const int K = g.K, nt = K / BK;
    unsigned voffA[2], voffB[2];
#pragma unroll
    for (int i = 0; i < 2; ++i) { int R, C; stage_rc(tid * 16 + i * 8192, R, C); const int Rb = Epi::PERM ? ((R & ~31) + perm32(R & 31)) : R;
        voffA[i] = (unsigned)(R * g.lda + C) * 2u; voffB[i] = (unsigned)(Rb * g.ldb + C) * 2u; }
    const size_t kstep = (size_t)(BK * 2);
    const size_t hstepA = (size_t)HALF * g.lda * 2, hstepB = (size_t)HALF * g.ldb * 2;
    const size_t tstepA = 2 * hstepA, tstepB = 2 * hstepB;
    const unsigned ldsw = (unsigned)wid * 1024u;
    const int aoff = lds_byte(wr * 64 + fr, fq * 8), boff = lds_byte(wc * 32 + fr, fq * 8);
#define PG8_SA(b, h) (((b) * 2 + (h)) * HTB)
#define PG8_SB(b, h) ((4 + (b) * 2 + (h)) * HTB)
#define PG8_STAGE(bufoff, gbase, voff) do { _Pragma("unroll") for (int _i = 0; _i < 2; ++_i) \
        __builtin_amdgcn_global_load_lds((const unsigned*)((const char*)(gbase) + (voff)[_i]), (LAS unsigned*)(lds + (bufoff) + ldsw + _i * 8192), 16, 0, 0); } while (0)
#define PG8_LDA(dst, b, h) do { _Pragma("unroll") for (int m = 0; m < 4; ++m) _Pragma("unroll") for (int k = 0; k < 2; ++k) dst[m][k] = *(const LAS bf16x8*)(lds + PG8_SA(b, h) + aoff + m * 2048 + k * 1024); } while (0)
#define PG8_LDB(dst, b, h) do { _Pragma("unroll") for (int n = 0; n < 2; ++n) _Pragma("unroll") for (int k = 0; k < 2; ++k) dst[n][k] = *(const LAS bf16x8*)(lds + PG8_SB(b, h) + boff + n * 2048 + k * 1024); } while (0)
#define PG8_MMA(ai, bj, At, Bt) do { __builtin_amdgcn_s_setprio(1); _Pragma("unroll") for (int m = 0; m < 4; ++m) _Pragma("unroll") for (int n = 0; n < 2; ++n) _Pragma("unroll") for (int k = 0; k < 2; ++k) \
        acc[ai][bj][m][n] = MmaOp<Epi::I8>::run(Bt[n][k], At[m][k], acc[ai][bj][m][n]); __builtin_amdgcn_s_setprio(0); } while (0)
#define PG8_WAIT_V(n) asm volatile("s_waitcnt vmcnt(" #n ")" ::: "memory")
#define PG8_WAIT_L(n) asm volatile("s_waitcnt lgkmcnt(" #n ")" ::: "memory")
#define PG8_BAR __builtin_amdgcn_s_barrier()
#define PG8_SCHED __builtin_amdgcn_sched_barrier(0)
    Unit cur, nxt; int ui = 0;
    if (!S.next(0, cur)) return;
    typedef typename Epi::acc_t acc_t;
    acc_t acc[2][2][4][2];
#pragma unroll
    for (int a = 0; a < 2; ++a)
#pragma unroll
        for (int b = 0; b < 2; ++b)
#pragma unroll
            for (int m = 0; m < 4; ++m)
#pragma unroll
                for (int n = 0; n < 2; ++n) acc[a][b][m][n] = (acc_t){0, 0, 0, 0};
    bf16x8 At[4][2], B0[2][2], B1[2][2];
    const char* cA = (const char*)g.A + (size_t)cur.pm * tstepA; const char* cB = (const char*)g.Bt + (size_t)cur.pn * tstepB;
    PG8_STAGE(PG8_SB(0, 0), cB, voffB); PG8_STAGE(PG8_SA(0, 0), cA, voffA); PG8_STAGE(PG8_SB(0, 1), cB + hstepB, voffB); PG8_STAGE(PG8_SA(0, 1), cA + hstepA, voffA);
    if (wr == 1) PG8_BAR;
    PG8_WAIT_V(4); PG8_BAR;
    PG8_STAGE(PG8_SB(1, 0), cB + kstep, voffB); PG8_STAGE(PG8_SA(1, 0), cA + kstep, voffA); PG8_STAGE(PG8_SB(1, 1), cB + hstepB + kstep, voffB);
    PG8_WAIT_V(6); PG8_BAR;
    for (;;) {
        const bool has_next = S.next(ui + 1, nxt);
        const char* nA = has_next ? (const char*)g.A + (size_t)nxt.pm * tstepA : cA; const char* nB = has_next ? (const char*)g.Bt + (size_t)nxt.pn * tstepB : cB;
        for (int t = 0; t < nt; t += 2) {
            const bool last = (t == nt - 2);
            const char* a1 = cA + (size_t)(t + 1) * kstep;
            const char* a2 = last ? nA : cA + (size_t)(t + 2) * kstep; const char* b2 = last ? nB : cB + (size_t)(t + 2) * kstep;
            const char* a3 = a2 + kstep; const char* b3 = b2 + kstep;
            PG8_LDB(B0, 0, 0); PG8_SCHED; PG8_LDA(At, 0, 0); PG8_STAGE(PG8_SA(1, 1), a1 + hstepA, voffA);
            PG8_WAIT_L(8); PG8_BAR; PG8_WAIT_L(0); PG8_MMA(0, 0, At, B0); PG8_BAR; PG8_SCHED;
            PG8_LDB(B1, 0, 1); PG8_STAGE(PG8_SB(0, 0), b2, voffB);
            PG8_BAR; PG8_WAIT_L(0); PG8_MMA(0, 1, At, B1); PG8_BAR;
            PG8_LDA(At, 0, 1); PG8_STAGE(PG8_SA(0, 0), a2, voffA);
            PG8_BAR; PG8_WAIT_L(0); PG8_MMA(1, 0, At, B0); PG8_BAR; PG8_SCHED;
            PG8_STAGE(PG8_SB(0, 1), b2 + hstepB, voffB);
            PG8_WAIT_V(6); PG8_BAR; PG8_MMA(1, 1, At, B1); PG8_BAR;
            PG8_LDB(B0, 1, 0); PG8_SCHED; PG8_LDA(At, 1, 0); PG8_STAGE(PG8_SA(0, 1), a2 + hstepA, voffA);
            PG8_WAIT_L(8); PG8_BAR; PG8_WAIT_L(0); PG8_MMA(0, 0, At, B0); PG8_BAR; PG8_SCHED;
            PG8_LDB(B1, 1, 1); PG8_STAGE(PG8_SB(1, 0), b3, voffB);
            PG8_BAR; PG8_WAIT_L(0); PG8_MMA(0, 1, At, B1); PG8_BAR;
            PG8_LDA(At, 1, 1); PG8_STAGE(PG8_SA(1, 0), a3, voffA);
            PG8_BAR; PG8_WAIT_L(0); PG8_MMA(1, 0, At, B0); PG8_BAR; PG8_SCHED;
            PG8_STAGE(PG8_SB(1, 1), b3 + hstepB, voffB);
            PG8_WAIT_V(6); PG8_BAR; PG8_MMA(1, 1, At, B1); PG8_BAR;
        }
        E(acc, cur, wr, wc, fr, fq);
        if (!has_next) break;
#pragma unroll
        for (int a = 0; a < 2; ++a)
#pragma unroll
            for (int b = 0; b < 2; ++b)
#pragma unroll
                for (int m = 0; m < 4; ++m)
#pragma unroll
                    for (int n = 0; n < 2; ++n) acc[a][b][m][n] = (acc_t){0, 0, 0, 0};
        cur = nxt; cA = nA; cB = nB; ++ui;
    }
    PG8_WAIT_V(0);
    if (wr == 0) PG8_BAR;
    PG8_BAR;
#undef PG8_SA
#undef PG8_SB
#undef PG8_STAGE
#undef PG8_LDA
#undef PG8_LDB
#undef PG8_MMA
#undef PG8_WAIT_V
#undef PG8_WAIT_L
#undef PG8_BAR
#undef PG8_SCHED
}
}

namespace att {
constexpr int D = 128, NW = 8, QBLK = 32, KVBLK = 64;
constexpr float SCALE = 0.088388347648318440f;
constexpr float THR = 8.f;
constexpr int LDQ = NQKV, LDK = NQKV, LDO = DM;
constexpr size_t SHM_V = KVBLK * D * 2, SHM_K = KVBLK * D * 2;
constexpr size_t SHM_WS = 2 * SHM_V + 2 * SHM_K, SHM_RPB = SHM_WS + NW * 64 * 4, SHM_ATTN = SHM_RPB + 512 * 4;
#define KSWZ(row, colB) ((row) * 256 + ((colB) ^ (((row) & 7) << 4)))
#define SBAR() __builtin_amdgcn_sched_barrier(0)
__device__ __forceinline__ int crow(int r, int hi) { return (r & 3) + 8 * (r >> 2) + 4 * hi; }
__device__ __forceinline__ bf16x8 ld8(const bf16_t* p) { return *reinterpret_cast<const bf16x8*>(p); }

__device__ __forceinline__ void partialSM(f32x16& p0, f32x16& p1, float& m_reg, float& mn, float& alpha) {
    constexpr float C = SCALE * LOG2E;
    float pmax = p0[0];
#pragma unroll
    for (int r = 1; r < 16; ++r) pmax = fmaxf(pmax, p0[r]);
#pragma unroll
    for (int r = 0; r < 16; ++r) pmax = fmaxf(pmax, p1[r]);
    { auto rr = __builtin_amdgcn_permlane32_swap(__float_as_uint(pmax), __float_as_uint(pmax), false, false);
      pmax = fmaxf(__uint_as_float(rr[0]), __uint_as_float(rr[1])); }
    if (__builtin_expect(__all(pmax - m_reg <= THR / SCALE), 1)) { mn = m_reg; alpha = 1.f; }
    else { mn = fmaxf(m_reg, pmax); alpha = __builtin_amdgcn_exp2f((m_reg - mn) * C); m_reg = mn; }
    const float mnC = -mn * C;
#pragma unroll
    for (int r = 0; r < 16; ++r) p0[r] = fmaf(p0[r], C, mnC);
#pragma unroll
    for (int r = 0; r < 16; ++r) p1[r] = fmaf(p1[r], C, mnC);
#pragma unroll
    for (int r = 0; r < 16; ++r) p0[r] = __builtin_amdgcn_exp2f(p0[r]);
}
#define PK4(P, BASE, OUT) do { unsigned a0 = cvt_pk_bf16(P[BASE + 0], P[BASE + 1]), a1 = cvt_pk_bf16(P[BASE + 2], P[BASE + 3]);   \
    unsigned b0 = cvt_pk_bf16(P[BASE + 4], P[BASE + 5]), b1 = cvt_pk_bf16(P[BASE + 6], P[BASE + 7]);                              \
    auto r0 = __builtin_amdgcn_permlane32_swap(a0, b0, false, false); auto r1 = __builtin_amdgcn_permlane32_swap(a1, b1, false, false); \
    u32x4 w = {r0[0], r1[0], r0[1], r1[1]}; OUT = *reinterpret_cast<bf16x8*>(&w); } while (0)
__device__ __forceinline__ void finishSM(f32x16& p0, f32x16& p1, float alpha, float& l_reg, bf16x8& pa0, bf16x8& pa1, bf16x8& pa2, bf16x8& pa3) {
#pragma unroll
    for (int r = 0; r < 16; ++r) p1[r] = __builtin_amdgcn_exp2f(p1[r]);
    float ps = 0;
#pragma unroll
    for (int r = 0; r < 16; ++r) ps += p0[r];
#pragma unroll
    for (int r = 0; r < 16; ++r) ps += p1[r];
    { auto rr = __builtin_amdgcn_permlane32_swap(__float_as_uint(ps), __float_as_uint(ps), false, false);
      ps = __uint_as_float(rr[0]) + __uint_as_float(rr[1]); }
    l_reg = l_reg * alpha + ps;
    PK4(p0, 0, pa0); PK4(p0, 8, pa1); PK4(p1, 0, pa2); PK4(p1, 8, pa3);
}
__device__ __forceinline__ void qkt(f32x16& p0, f32x16& p1, const bf16_t* Ks, const bf16x8* qr, int r32, int hi) {
    p0 = f32x16{}; p1 = f32x16{};
#pragma unroll
    for (int d0 = 0; d0 < 8; ++d0) { const int cb = (d0 * 16 + hi * 8) * 2;
        bf16x8 b0 = *reinterpret_cast<const bf16x8*>((const char*)Ks + KSWZ(r32, cb));
        bf16x8 b1 = *reinterpret_cast<const bf16x8*>((const char*)Ks + KSWZ(32 + r32, cb));
        p0 = __builtin_amdgcn_mfma_f32_32x32x16_bf16(b0, qr[d0], p0, 0, 0, 0);
        p1 = __builtin_amdgcn_mfma_f32_32x32x16_bf16(b1, qr[d0], p1, 0, 0, 0); }
}
__device__ __forceinline__ int v_st(int k, int c) { const int kk = (k & ~0xC) | ((k & 4) << 1) | ((k & 8) >> 1); return ((kk >> 3) * 4 + (c >> 5)) * 512 + ((kk & 7) * 32 + (c & 31)) * 2; }
__device__ __forceinline__ int v_rd_base(int lane) { return ((lane & 3) << 3) | (((lane >> 2) & 3) << 6) | (((lane >> 4) & 1) << 5) | (((lane >> 5) & 1) << 8); }
constexpr int v_rd_off(int d0, int ks, int half) { return d0 * 512 + ks * 4096 + half * 2048; }
template <int OFF> __device__ __forceinline__ s16x4 tr_read(int vb) {
    s16x4 r; asm volatile("ds_read_b64_tr_b16 %0, %1 offset:%2" : "=&v"(r) : "v"(vb), "i"(OFF) : "memory"); return r;
}
template <int D0> __device__ __forceinline__ void pv_one(f32x16& od, int vb, bf16x8 pa0, bf16x8 pa1, bf16x8 pa2, bf16x8 pa3) {
    const s16x4 l0 = tr_read<v_rd_off(D0, 0, 0)>(vb), h0 = tr_read<v_rd_off(D0, 0, 1)>(vb), l1 = tr_read<v_rd_off(D0, 1, 0)>(vb), h1 = tr_read<v_rd_off(D0, 1, 1)>(vb);
    const s16x4 l2 = tr_read<v_rd_off(D0, 2, 0)>(vb), h2 = tr_read<v_rd_off(D0, 2, 1)>(vb), l3 = tr_read<v_rd_off(D0, 3, 0)>(vb), h3 = tr_read<v_rd_off(D0, 3, 1)>(vb);
    asm volatile("s_waitcnt lgkmcnt(0)" ::: "memory"); SBAR();
#define PKV(L, H) (bf16x8){L[0], L[1], L[2], L[3], H[0], H[1], H[2], H[3]}
    od = __builtin_amdgcn_mfma_f32_32x32x16_bf16(pa0, PKV(l0, h0), od, 0, 0, 0);
    od = __builtin_amdgcn_mfma_f32_32x32x16_bf16(pa1, PKV(l1, h1), od, 0, 0, 0);
    od = __builtin_amdgcn_mfma_f32_32x32x16_bf16(pa2, PKV(l2, h2), od, 0, 0, 0);
    od = __builtin_amdgcn_mfma_f32_32x32x16_bf16(pa3, PKV(l3, h3), od, 0, 0, 0);
#undef PKV
}
__device__ __forceinline__ void pv_d0(f32x16* o, int vb, bf16x8 pa0, bf16x8 pa1, bf16x8 pa2, bf16x8 pa3) {
    pv_one<0>(o[0], vb, pa0, pa1, pa2, pa3); pv_one<1>(o[1], vb, pa0, pa1, pa2, pa3); pv_one<2>(o[2], vb, pa0, pa1, pa2, pa3); pv_one<3>(o[3], vb, pa0, pa1, pa2, pa3);
}

__device__ __forceinline__ void attn_dense_body(const bf16_t* Qb, const bf16_t* Kh, const bf16_t* Vh, bf16_t* Ob, int seq, char* lds) {
    int tid_ = threadIdx.x; asm volatile("" : "+v"(tid_));
    const int tid = tid_, wid = tid >> 6, lane = tid & 63, r32 = lane & 31, hi = lane >> 5;
    bf16_t* V_lds = (bf16_t*)lds; bf16_t* K_lds = (bf16_t*)(lds + 2 * SHM_V);
    float* ws = (float*)(lds + SHM_WS) + wid * 64; float* li_l = ws; float* al_l = ws + 32;
    float m_reg = -1e30f, l_reg = 0; f32x16 o[4] = {}; bf16x8 qr[8];
    const bf16_t* Qw = Qb + (long)(wid * QBLK + r32) * LDQ + hi * 8;
#pragma unroll
    for (int d0 = 0; d0 < 8; ++d0) qr[d0] = ld8(Qw + d0 * 16);
    const int sr = tid >> 4, sc = (tid & 15) * 8, vst0 = v_st(sr, sc), vst1 = v_st(32 + sr, sc);
    const int vb0 = (int)(uintptr_t)V_lds + v_rd_base(lane);
    struct { bf16x8 vs0, vs1, ks0, ks1; } sr_[2];
#define SLOAD(i, k0) do { sr_[i].vs0 = ld8(&Vh[(long)((k0) + sr) * LDK + sc]); sr_[i].vs1 = ld8(&Vh[(long)((k0) + 32 + sr) * LDK + sc]); \
    sr_[i].ks0 = ld8(&Kh[(long)((k0) + sr) * LDK + sc]); sr_[i].ks1 = ld8(&Kh[(long)((k0) + 32 + sr) * LDK + sc]); } while (0)
#define SWRITE(b, i) do { *(bf16x8*)((char*)V_lds + (b) * SHM_V + vst0) = sr_[i].vs0;          \
    *(bf16x8*)((char*)V_lds + (b) * SHM_V + vst1) = sr_[i].vs1; int kc = sc * 2;               \
    *(bf16x8*)((char*)K_lds + (b) * SHM_K + KSWZ(sr, kc)) = sr_[i].ks0;                       \
    *(bf16x8*)((char*)K_lds + (b) * SHM_K + KSWZ(32 + sr, kc)) = sr_[i].ks1; } while (0)
#define SWAIT() asm volatile("s_waitcnt vmcnt(4)" ::: "memory")
#define RESC(a) do { if (__any((a) < 1.f)) { if (hi == 0) al_l[r32] = (a); asm volatile("s_waitcnt lgkmcnt(0)" ::: "memory"); \
    _Pragma("unroll") for (int d = 0; d < 4; ++d) _Pragma("unroll") for (int r = 0; r < 16; ++r) o[d][r] *= al_l[crow(r, hi)]; } } while (0)
    f32x16 pA0, pA1, pB0, pB1; float mnA, mnB, alA, alB; bf16x8 pa0, pa1, pa2, pa3; const int NT = seq / KVBLK;
    constexpr int SE = 0, SO = 1;
    SLOAD(SE, 0); asm volatile("s_waitcnt vmcnt(0)" ::: "memory"); SWRITE(0, SE); __syncthreads();
    qkt(pA0, pA1, K_lds, qr, r32, hi); partialSM(pA0, pA1, m_reg, mnA, alA);
    SLOAD(SO, KVBLK); if (2 < NT) SLOAD(SE, 2 * KVBLK);
    SWAIT(); SWRITE(1, SO); __syncthreads();
    for (int j = 1; j + 1 < NT; j += 2) {
        SBAR(); qkt(pB0, pB1, (bf16_t*)((char*)K_lds + SHM_K), qr, r32, hi);
        finishSM(pA0, pA1, alA, l_reg, pa0, pa1, pa2, pa3); SBAR();
        SLOAD(SO, (j + 2) * KVBLK); SBAR();
        pv_d0(o, vb0, pa0, pa1, pa2, pa3); partialSM(pB0, pB1, m_reg, mnB, alB);
        __syncthreads(); SWAIT(); SWRITE(0, SE);
        RESC(alB); __syncthreads();
        SBAR(); qkt(pA0, pA1, K_lds, qr, r32, hi);
        finishSM(pB0, pB1, alB, l_reg, pa0, pa1, pa2, pa3); SBAR();
        if (j + 3 < NT) SLOAD(SE, (j + 3) * KVBLK); SBAR();
        pv_d0(o, vb0 + (int)SHM_V, pa0, pa1, pa2, pa3); partialSM(pA0, pA1, m_reg, mnA, alA);
        __syncthreads(); SWAIT(); SWRITE(1, SO);
        RESC(alA); __syncthreads();
    }
    SBAR(); qkt(pB0, pB1, (bf16_t*)((char*)K_lds + SHM_K), qr, r32, hi);
    finishSM(pA0, pA1, alA, l_reg, pa0, pa1, pa2, pa3); SBAR();
    pv_d0(o, vb0, pa0, pa1, pa2, pa3); partialSM(pB0, pB1, m_reg, mnB, alB);
    __syncthreads(); RESC(alB);
    finishSM(pB0, pB1, alB, l_reg, pa0, pa1, pa2, pa3); SBAR();
    pv_d0(o, vb0 + (int)SHM_V, pa0, pa1, pa2, pa3);
    if (hi == 0) li_l[r32] = l_reg; asm volatile("s_waitcnt lgkmcnt(0)" ::: "memory");
    int r32e = r32, hie = hi; asm volatile("" : "+v"(r32e), "+v"(hie));
    bf16_t* Ow = Ob + (long)(wid * QBLK) * LDO;
#pragma unroll
    for (int r = 0; r < 16; ++r) { const int orow = crow(r, hie); const float rl = __builtin_amdgcn_rcpf(li_l[orow]);
#pragma unroll
        for (int d0 = 0; d0 < 4; ++d0) Ow[(long)orow * LDO + d0 * 32 + r32e] = (bf16_t)(cvt_pk_bf16(o[d0][r] * rl, 0.f) & 0xffffu); }
#undef SLOAD
#undef SWRITE
#undef SWAIT
#undef RESC
}

__device__ __forceinline__ void na_unit(const bf16_t* QKV, bf16_t* YAB, const float* rpb, int rb, int h, char* lds) {
    int tid_ = threadIdx.x; asm volatile("" : "+v"(tid_));
    const int tid = tid_, wid = __builtin_amdgcn_readfirstlane(tid >> 6), lane = tid & 63, r32 = lane & 31, hi = lane >> 5;
    bf16_t* V_lds = (bf16_t*)lds; bf16_t* K_lds = (bf16_t*)(lds + 2 * SHM_V);
    float* wsf = (float*)(lds + SHM_WS) + wid * 64; float* li_l = wsf; float* al_l = wsf + 32;
    float* rp = (float*)(lds + SHM_RPB);
    const int tok0 = rb * 256;
    int tb, R;
    if (tok0 < MP) { tb = tok0 & ~4095; R = 64; } else { tb = MP + ((tok0 - MP) & ~2047); R = 32; }
    const int r0 = (tok0 - tb) >> 6;
    const int r = r0 + (wid >> 1), g = wid & 1, qc = g * 32 + r32;
    const int rs_w = min(max(r - 4, 0), R - 8);
    const int lo = min(max(r0 - 4, 0), R - 8), hiT = min(max(r0 - 1, 0), R - 8) + 8, ntile = hiT - lo;
    const int cs = min(max(qc - 8, 0), 48);
    __syncthreads();
    for (int i = tid; i < 465; i += 512) rp[i] = rpb[h * 465 + i] * LOG2E;
    bf16x8 qr[8];
    { const bf16_t* Qw = QKV + (size_t)(tb + r * 64 + qc) * LDQ + 1536 + h * 128 + hi * 8;
#pragma unroll
      for (int d0 = 0; d0 < 8; ++d0) qr[d0] = ld8(Qw + d0 * 16); }
    const bf16_t* Kh = QKV + (size_t)tb * LDQ + 2560 + h * 128; const bf16_t* Vh = QKV + (size_t)tb * LDQ + 3584 + h * 128;
    const int sr = tid >> 4, sc = (tid & 15) * 8, vst0 = v_st(sr, sc), vst1 = v_st(32 + sr, sc);
    const int vb0 = (int)(uintptr_t)V_lds + v_rd_base(lane);
    bf16x8 vs0, vs1, ks0, ks1;
#define NLOAD(kr) do { const long k0 = (long)(kr) * 64; vs0 = ld8(&Vh[(k0 + sr) * LDK + sc]); vs1 = ld8(&Vh[(k0 + 32 + sr) * LDK + sc]); \
    ks0 = ld8(&Kh[(k0 + sr) * LDK + sc]); ks1 = ld8(&Kh[(k0 + 32 + sr) * LDK + sc]); } while (0)
#define NWRITE(b) do { *(bf16x8*)((char*)V_lds + (b) * SHM_V + vst0) = vs0; *(bf16x8*)((char*)V_lds + (b) * SHM_V + vst1) = vs1; \
    *(bf16x8*)((char*)K_lds + (b) * SHM_K + KSWZ(sr, sc * 2)) = ks0; *(bf16x8*)((char*)K_lds + (b) * SHM_K + KSWZ(32 + sr, sc * 2)) = ks1; } while (0)
    NLOAD(lo);
    float m_reg = -1e30f, l_reg = 0.f; f32x16 o[4] = {};
    constexpr float C = SCALE * LOG2E;
    for (int t = 0; t < ntile; ++t) {
        const int kr = lo + t, b = t & 1;
        NWRITE(b);
        if (t + 1 < ntile) NLOAD(kr + 1);
        __syncthreads();
        if (kr >= rs_w && kr < rs_w + 8) {
            f32x16 p0, p1;
            qkt(p0, p1, (const bf16_t*)((const char*)K_lds + b * SHM_K), qr, r32, hi);
            const float* rprow = rp + (kr - r + 7) * 31;
            float pmax = -1e30f;
#pragma unroll
            for (int rr = 0; rr < 16; ++rr) {
                const int kc0 = crow(rr, hi), kc1 = kc0 + 32;
                const bool v0 = (kc0 >= cs) && (kc0 < cs + 16), v1 = (kc1 >= cs) && (kc1 < cs + 16);
                const float b0 = rprow[min(max(kc0 - qc + 15, 0), 30)], b1 = rprow[min(max(kc1 - qc + 15, 0), 30)];
                p0[rr] = v0 ? fmaf(p0[rr], C, b0) : -1e30f; p1[rr] = v1 ? fmaf(p1[rr], C, b1) : -1e30f;
                pmax = fmaxf(pmax, fmaxf(p0[rr], p1[rr]));
            }
            { auto sw = __builtin_amdgcn_permlane32_swap(__float_as_uint(pmax), __float_as_uint(pmax), false, false);
              pmax = fmaxf(__uint_as_float(sw[0]), __uint_as_float(sw[1])); }
            const float mn = fmaxf(m_reg, pmax), alpha = __builtin_amdgcn_exp2f(m_reg - mn); m_reg = mn;
            float ps = 0.f;
#pragma unroll
            for (int rr = 0; rr < 16; ++rr) { p0[rr] = __builtin_amdgcn_exp2f(p0[rr] - mn); p1[rr] = __builtin_amdgcn_exp2f(p1[rr] - mn); ps += p0[rr] + p1[rr]; }
            { auto sw = __builtin_amdgcn_permlane32_swap(__float_as_uint(ps), __float_as_uint(ps), false, false);
              ps = __uint_as_float(sw[0]) + __uint_as_float(sw[1]); }
            l_reg = l_reg * alpha + ps;
            if (hi == 0) al_l[r32] = alpha;
            asm volatile("s_waitcnt lgkmcnt(0)" ::: "memory");
#pragma unroll
            for (int d = 0; d < 4; ++d)
#pragma unroll
                for (int rr = 0; rr < 16; ++rr) o[d][rr] *= al_l[crow(rr, hi)];
            bf16x8 pa0, pa1, pa2, pa3;
            PK4(p0, 0, pa0); PK4(p0, 8, pa1); PK4(p1, 0, pa2); PK4(p1, 8, pa3);
            pv_d0(o, vb0 + b * (int)SHM_V, pa0, pa1, pa2, pa3);
        }
    }
    if (hi == 0) li_l[r32] = l_reg; asm volatile("s_waitcnt lgkmcnt(0)" ::: "memory");
    int r32e = r32, hie = hi; asm volatile("" : "+v"(r32e), "+v"(hie));
    bf16_t* Ow = YAB + (size_t)(tb + r * 64 + g * 32) * LDO + 1024 + h * 128;
#pragma unroll
    for (int rr = 0; rr < 16; ++rr) { const int orow = crow(rr, hie); const float rl = __builtin_amdgcn_rcpf(li_l[orow]);
#pragma unroll
        for (int d0 = 0; d0 < 4; ++d0) Ow[(long)orow * LDO + d0 * 32 + r32e] = (bf16_t)(cvt_pk_bf16(o[d0][rr] * rl, 0.f) & 0xffffu); }
#undef NLOAD
#undef NWRITE
}
}


#define XB_TMO      128
#define XB_XCNT(j)  (256  + 64 * (j))
#define XB_XSUB(j)  (1280 + 64 * (j))
#define XB_XGEN(j)  (2304 + 64 * (j))
#define XB_TOP      3328
#define XB_TOPGEN   3392
#define XCD_BAR_WORDS 3456
#define XB_SPIN_CAP (1u << 18)
__device__ __forceinline__ unsigned xb_ld(unsigned* p)              { return __hip_atomic_load(p, __ATOMIC_RELAXED, __HIP_MEMORY_SCOPE_AGENT); }
__device__ __forceinline__ unsigned xb_add(unsigned* p, unsigned v) { return __hip_atomic_fetch_add(p, v, __ATOMIC_RELAXED, __HIP_MEMORY_SCOPE_AGENT); }
__device__ __forceinline__ unsigned xb_xcc_id() { return (unsigned)__builtin_amdgcn_s_getreg((3 << 11) | 20) & 0xFu; }
#define XB_SPIN(cond, bar) do { unsigned _sp = 0; while (cond) { __builtin_amdgcn_s_sleep(1); \
    if ((++_sp & 255u) == 0u) { if (xb_ld(&(bar)[XB_TMO])) break; if (_sp > XB_SPIN_CAP) { atomicAdd(&(bar)[XB_TMO], 1u); break; } } } } while (0)
struct XcdBarrier { unsigned* bar; unsigned x; volatile LAS unsigned* st; };
__device__ __forceinline__ XcdBarrier xcd_barrier_post(unsigned* bar, volatile LAS unsigned* st) {
    XcdBarrier b; b.bar = bar; b.x = xb_xcc_id(); b.st = st;
    if (threadIdx.x == 0) (void)xb_add(&bar[XB_XCNT(b.x)], 1u);
    return b;
}
__device__ __forceinline__ void xcd_barrier_complete(unsigned* bar, unsigned x, unsigned& nloc, unsigned& nx) {
    const unsigned G = gridDim.x * gridDim.y * gridDim.z;
    unsigned sum, cnt, mine, sp = 0u;
    for (;;) {
        sum = 0u; cnt = 0u; mine = 0u;
#pragma unroll
        for (unsigned j = 0; j < 16; ++j) { const unsigned c = xb_ld(&bar[XB_XCNT(j)]); sum += c; cnt += (c > 0u) ? 1u : 0u; mine = (j == x) ? c : mine; }
        if (sum == G) break;
        __builtin_amdgcn_s_sleep(1);
        if ((++sp & 255u) == 0u) { if (xb_ld(&bar[XB_TMO])) break; if (sp > XB_SPIN_CAP) { atomicAdd(&bar[XB_TMO], 1u); break; } }
    }
    nloc = mine > 0u ? mine : 1u; nx = cnt > 0u ? cnt : 1u;
}
__device__ __forceinline__ void xcd_barrier(const XcdBarrier& b) {
    asm volatile("s_waitcnt vmcnt(0)" ::: "memory");
    __syncthreads();
    if (threadIdx.x == 0) {
        unsigned* bar = b.bar;
        __builtin_amdgcn_s_waitcnt(0);
        unsigned nloc = b.st[0], nx = b.st[1];
        if (nloc == 0u) { xcd_barrier_complete(bar, b.x, nloc, nx); b.st[0] = nloc; b.st[1] = nx; }
        const unsigned old = xb_add(&bar[XB_XSUB(b.x)], 1u);
        const unsigned gen = old / nloc;
        if (old + 1u == (gen + 1u) * nloc) {
            __builtin_amdgcn_fence(__ATOMIC_RELEASE, "agent");
            asm volatile("s_waitcnt vmcnt(0)" ::: "memory");
            const unsigned og = xb_add(&bar[XB_TOP], 1u);
            const unsigned tg = og / nx;
            if (og + 1u == (tg + 1u) * nx) xb_add(&bar[XB_TOPGEN], 1u);
            else XB_SPIN(xb_ld(&bar[XB_TOPGEN]) == tg, bar);
            __builtin_amdgcn_fence(__ATOMIC_ACQUIRE, "agent");
            xb_add(&bar[XB_XGEN(b.x)], 1u);
            asm volatile("s_waitcnt vmcnt(0)" ::: "memory");
        } else {
            XB_SPIN(xb_ld(&bar[XB_XGEN(b.x)]) == gen, bar);
            __builtin_amdgcn_fence(__ATOMIC_ACQUIRE, "agent");
            asm volatile("s_waitcnt vmcnt(0)" ::: "memory");
        }
    }
    __syncthreads();
}

constexpr size_t WS_SSQ1 = 0, WS_SSQ2 = 98304, WS_SSQ3 = 196608, WS_BAR = 294912, WS_COLMAX = 308736, WS_COLMAX1 = 343552, WS_SWINV = 387584, WS_FR = 422400, WS_RSQ = 520704, CTL_BYTES = 1u << 20;
constexpr size_t WS_W1A = CTL_BYTES;
constexpr size_t WS_W1B = WS_W1A + (size_t)2 * FF * DM * 2;
constexpr size_t WS_WIN = WS_W1B + (size_t)DM * FF * 2;
constexpr size_t WS_WA = WS_WIN + (size_t)NIN * DM * 2;
constexpr size_t WS_WB = WS_WA + (size_t)DM * 1024 * 2;
constexpr size_t WS_WOUT = WS_WB + (size_t)DM * 1024 * 2;
constexpr size_t WS_HB = WS_WOUT + (size_t)DM * DM * 2;
constexpr size_t WS_R1 = WS_HB + (size_t)M * DM * 2;
constexpr size_t WS_YAB = WS_R1 + (size_t)M * NQKV * 2;
constexpr size_t WS_END = WS_YAB + (size_t)M * DM * 2;
static_assert(WS_R1 + (size_t)M * FF * 2 <= WS_END, "ACT fits");

constexpr int LDS_BYTES = 147456;
constexpr int N_PHASES = 14;

struct Args { const float* in[18]; float* out; unsigned char* ws; int ph_lo, ph_hi; };

template <int MODE>
__device__ __forceinline__ void transpose_item(const float* W, int K, int N, bf16_t* WT, const float* gain, LAS float* scr, int item, int lane) {
    const int nblk = N / 32, kb = item / nblk, nb = item % nblk, k0 = 64 * kb, n0 = 32 * nb;
    int d0 = n0;
    if (MODE == 1) { const int up = n0 >= FF, j = up ? n0 - FF : n0; d0 = (j >> 7) * 256 + up * 128 + (j & 127); }
#pragma unroll
    for (int i = 0; i < 32; ++i) { const int kk = 2 * i + (lane >> 5); float v = W[(size_t)(k0 + kk) * N + n0 + (lane & 31)]; if (gain) v *= gain[k0 + kk]; scr[kk * 33 + (lane & 31)] = v; }
    asm volatile("s_waitcnt lgkmcnt(0)" ::: "memory");
    const int c = lane & 7;
#pragma unroll
    for (int j = 0; j < 4; ++j) { const int n = (lane >> 3) + 8 * j; const LAS float* s = scr + (8 * c) * 33 + n;
        u32x4 o; o.x = cvt_pk_bf16(s[0 * 33], s[1 * 33]); o.y = cvt_pk_bf16(s[2 * 33], s[3 * 33]); o.z = cvt_pk_bf16(s[4 * 33], s[5 * 33]); o.w = cvt_pk_bf16(s[6 * 33], s[7 * 33]);
        *(u32x4*)(WT + (size_t)(d0 + n) * K + k0 + 8 * c) = o; }
    asm volatile("s_waitcnt lgkmcnt(0)" ::: "memory");
}

template <int MODE> __device__ __forceinline__ void quant_item(const float* W, int K, int N, unsigned char* W8, const float* gain, const float* colmax, float* swinv, LAS float* scr, int item, int lane) {
    const int nblk = N / 32, kb = item / nblk, nb = item % nblk, k0 = 64 * kb, n0 = 32 * nb;
    int d0 = n0;
    if (MODE == 1) { const int up = n0 >= FF, jj = up ? n0 - FF : n0; d0 = (jj >> 7) * 256 + up * 128 + (jj & 127); }
#pragma unroll
    for (int i = 0; i < 32; ++i) { const int kk = 2 * i + (lane >> 5); scr[kk * 33 + (lane & 31)] = W[(size_t)(k0 + kk) * N + n0 + (lane & 31)] * gain[k0 + kk]; }
    asm volatile("s_waitcnt lgkmcnt(0)" ::: "memory");
    const int c = lane & 7;
#pragma unroll
    for (int j = 0; j < 4; ++j) { const int n = (lane >> 3) + 8 * j; const LAS float* sp = scr + (8 * c) * 33 + n;
        const float cm = ld_agent(colmax + n0 + n), sc = cm > 0.f ? 127.f / cm : 0.f;
        unsigned w0 = 0u, w1 = 0u;
#pragma unroll
        for (int e = 0; e < 4; ++e) { int q0 = (int)rintf(sp[e * 33] * sc), q1 = (int)rintf(sp[(e + 4) * 33] * sc);
            q0 = q0 < -127 ? -127 : (q0 > 127 ? 127 : q0); q1 = q1 < -127 ? -127 : (q1 > 127 ? 127 : q1);
            w0 |= ((unsigned)q0 & 0xffu) << (8 * e); w1 |= ((unsigned)q1 & 0xffu) << (8 * e); }
        u32x2 o; o.x = w0; o.y = w1;
        *(u32x2*)(W8 + (size_t)(d0 + n) * K + k0 + 8 * c) = o;
        if (kb == 0 && c == 0) swinv[d0 + n] = cm * (1.f / 127.f); }
    asm volatile("s_waitcnt lgkmcnt(0)" ::: "memory");
}

template <int MODE, bool GAIN>
__device__ __forceinline__ void item_loads(const float* W, int N, const float* gain, int item, int lane, float (&r)[32]) {
    const int nblk = N / 32, kb = item / nblk, nb = item % nblk, k0 = 64 * kb, n0 = 32 * nb;
#pragma unroll
    for (int i = 0; i < 32; ++i) { const int kk = 2 * i + (lane >> 5); float v = W[(size_t)(k0 + kk) * N + n0 + (lane & 31)]; if (GAIN) v *= gain[k0 + kk]; r[i] = v; }
}
template <int MODE, bool GAIN>
__device__ __forceinline__ void transpose_loop2(const float* W, int K, int N, bf16_t* WT, const float* gain, LAS float* scr, int first, int n, int stride, int lane);
template <int MODE, bool GAIN>
__device__ __forceinline__ void quant_loop2(const float* W, int K, int N, unsigned char* W8, const float* gain, const float* colmax, float* swinv, LAS float* scr, int first, int n, int stride, int lane);
__device__ __forceinline__ int item_d0(int n0, int mode) { if (mode != 1) return n0; const int up = n0 >= FF, jj = up ? n0 - FF : n0; return (jj >> 7) * 256 + up * 128 + (jj & 127); }
template <int MODE>
__device__ __forceinline__ void transpose_finish(const float (&r)[32], int K, int N, bf16_t* WT, LAS float* scr, int item, int lane) {
    const int nblk = N / 32, kb = item / nblk, nb = item % nblk, k0 = 64 * kb, d0 = item_d0(32 * nb, MODE);
#pragma unroll
    for (int i = 0; i < 32; ++i) { const int kk = 2 * i + (lane >> 5); scr[kk * 33 + (lane & 31)] = r[i]; }
    asm volatile("s_waitcnt lgkmcnt(0)" ::: "memory");
    const int c = lane & 7;
#pragma unroll
    for (int j = 0; j < 4; ++j) { const int n = (lane >> 3) + 8 * j; const LAS float* sp = scr + (8 * c) * 33 + n;
        u32x4 o; o.x = cvt_pk_bf16(sp[0 * 33], sp[1 * 33]); o.y = cvt_pk_bf16(sp[2 * 33], sp[3 * 33]); o.z = cvt_pk_bf16(sp[4 * 33], sp[5 * 33]); o.w = cvt_pk_bf16(sp[6 * 33], sp[7 * 33]);
        *(u32x4*)(WT + (size_t)(d0 + n) * K + k0 + 8 * c) = o; }
    asm volatile("s_waitcnt lgkmcnt(0)" ::: "memory");
}
template <int MODE>
__device__ __forceinline__ void quant_finish(const float (&r)[32], int K, int N, unsigned char* W8, const float* colmax, float* swinv, LAS float* scr, int item, int lane) {
    const int nblk = N / 32, kb = item / nblk, nb = item % nblk, k0 = 64 * kb, n0 = 32 * nb, d0 = item_d0(n0, MODE);
#pragma unroll
    for (int i = 0; i < 32; ++i) { const int kk = 2 * i + (lane >> 5); scr[kk * 33 + (lane & 31)] = r[i]; }
    asm volatile("s_waitcnt lgkmcnt(0)" ::: "memory");
    const int c = lane & 7;
#pragma unroll
    for (int j = 0; j < 4; ++j) { const int n = (lane >> 3) + 8 * j; const LAS float* sp = scr + (8 * c) * 33 + n;
        const float cm = ld_agent(colmax + n0 + n), sc = cm > 0.f ? 127.f / cm : 0.f;
        unsigned w0 = 0u, w1 = 0u;
#pragma unroll
        for (int e = 0; e < 4; ++e) { int q0 = (int)rintf(sp[e * 33] * sc), q1 = (int)rintf(sp[(e + 4) * 33] * sc);
            q0 = q0 < -127 ? -127 : (q0 > 127 ? 127 : q0); q1 = q1 < -127 ? -127 : (q1 > 127 ? 127 : q1);
            w0 |= ((unsigned)q0 & 0xffu) << (8 * e); w1 |= ((unsigned)q1 & 0xffu) << (8 * e); }
        u32x2 o; o.x = w0; o.y = w1;
        *(u32x2*)(W8 + (size_t)(d0 + n) * K + k0 + 8 * c) = o;
        if (kb == 0 && c == 0) swinv[d0 + n] = cm * (1.f / 127.f); }
    asm volatile("s_waitcnt lgkmcnt(0)" ::: "memory");
}

template <int MODE, bool GAIN>
__device__ __forceinline__ void transpose_loop2(const float* W, int K, int N, bf16_t* WT, const float* gain, LAS float* scr, int first, int n, int stride, int lane) {
    for (int it = first; it < n; it += 2 * stride) { const int itB = it + stride; float ra[32], rb[32];
        item_loads<MODE, GAIN>(W, N, gain, it, lane, ra); if (itB < n) item_loads<MODE, GAIN>(W, N, gain, itB, lane, rb);
        transpose_finish<MODE>(ra, K, N, WT, scr, it, lane); if (itB < n) transpose_finish<MODE>(rb, K, N, WT, scr, itB, lane); }
}
template <int MODE, bool GAIN>
__device__ __forceinline__ void quant_loop2(const float* W, int K, int N, unsigned char* W8, const float* gain, const float* colmax, float* swinv, LAS float* scr, int first, int n, int stride, int lane) {
    for (int it = first; it < n; it += 2 * stride) { const int itB = it + stride; float ra[32], rb[32];
        item_loads<MODE, GAIN>(W, N, gain, it, lane, ra); if (itB < n) item_loads<MODE, GAIN>(W, N, gain, itB, lane, rb);
        quant_finish<MODE>(ra, K, N, W8, colmax, swinv, scr, it, lane); if (itB < n) quant_finish<MODE>(rb, K, N, W8, colmax, swinv, scr, itB, lane); }
}

__global__ void __launch_bounds__(512, 2) mk_fwd(Args args) {
    extern __shared__ __attribute__((aligned(16))) unsigned char lds[];
    LAS unsigned char* ldsl = (LAS unsigned char*)lds;
    const int tid = threadIdx.x, lane = tid & 63, wave = __builtin_amdgcn_readfirstlane(tid >> 6);
    const int G = gridDim.x, bx = blockIdx.x;
    const int gw = bx * 8 + wave, NGW = G * 8;
    unsigned char* ws = args.ws;
    const float* x_prompt = args.in[0]; const float* x_sample = args.in[1];
    float* ssq1 = (float*)(ws + WS_SSQ1); float* ssq2 = (float*)(ws + WS_SSQ2); float* ssq3 = (float*)(ws + WS_SSQ3); float* colmax = (float*)(ws + WS_COLMAX); float* swinv = (float*)(ws + WS_SWINV); float* frow = (float*)(ws + WS_FR);
    bf16_t* W1A = (bf16_t*)(ws + WS_W1A); bf16_t* W1B = (bf16_t*)(ws + WS_W1B); bf16_t* WIN = (bf16_t*)(ws + WS_WIN);
    bf16_t* WA = (bf16_t*)(ws + WS_WA); bf16_t* WB = (bf16_t*)(ws + WS_WB); bf16_t* WOUT = (bf16_t*)(ws + WS_WOUT);
    bf16_t* HB = (bf16_t*)(ws + WS_HB); bf16_t* ACT = (bf16_t*)(ws + WS_R1); bf16_t* QKV = (bf16_t*)(ws + WS_R1); bf16_t* GT = (bf16_t*)(ws + WS_R1);
    bf16_t* YAB = (bf16_t*)(ws + WS_YAB);
    float* out = args.out;
    const int lo = args.ph_lo, hi = args.ph_hi;
    volatile LAS unsigned* bst = (volatile LAS unsigned*)(ldsl + 140288);
    if (tid < 2) bst[tid] = 0u;
    __syncthreads();
    const XcdBarrier xbar = xcd_barrier_post((unsigned*)(ws + WS_BAR), bst);
#ifndef PH_MASK
#define PH_MASK 0xffff
#endif
#define IN(k) (((PH_MASK >> (k)) & 1) && lo <= (k) && (k) < hi)
#if MK_PER_PHASE
#define SEAM(k) do { } while (0)
#else
#define SEAM(k) do { if (IN(k) && IN((k) + 1)) { if ((k) == 0) cg::this_grid().sync(); else xcd_barrier(xbar); } } while (0)
#endif

    if (IN(0)) {
        LAS float* scr = (LAS float*)(ldsl + wave * 16384);
        constexpr int I_1A = (DM / 64) * (2 * FF / 32);
        {
            const float* Win = args.in[6]; const float* gm = args.in[5];
            for (int t = bx * 512 + tid; t < 64 * NIN; t += G * 512) {
                const int ch = t / NIN, n = t - ch * NIN; float mx = 0.f;
#pragma unroll
                for (int k = ch * 32; k < ch * 32 + 32; ++k) mx = fmaxf(mx, fabsf(Win[(size_t)k * NIN + n] * gm[k]));
                atomicMax((int*)colmax + n, __float_as_int(mx));
            }
        }
        float* colmax1 = (float*)(ws + WS_COLMAX1); float* swinv1 = (float*)(ws + 650240); float* frow1 = (float*)(ws + 700416);
        {
            const float* W1 = args.in[3]; const float* g1 = args.in[2];
            for (int t = bx * 512 + tid; t < 64 * 2 * FF; t += G * 512) {
                const int ch = t / (2 * FF), n = t - ch * (2 * FF); float mx = 0.f;
#pragma unroll
                for (int k = ch * 32; k < ch * 32 + 32; ++k) mx = fmaxf(mx, fabsf(W1[(size_t)k * (2 * FF) + n] * g1[k]));
                atomicMax((int*)colmax1 + n, __float_as_int(mx));
            }
        }
        for (int m0 = gw; m0 < M; m0 += 2 * NGW) {
            f32x4 v[2][8]; int mm[2];
#pragma unroll
            for (int rr = 0; rr < 2; ++rr) { mm[rr] = (m0 + rr * NGW < M) ? m0 + rr * NGW : m0;
                const float* xr = (mm[rr] < MP) ? x_prompt + (size_t)mm[rr] * DM : x_sample + (size_t)(mm[rr] - MP) * DM;
                const f32x4* x4 = (const f32x4*)xr + lane;
#pragma unroll
                for (int j = 0; j < 8; ++j) v[rr][j] = x4[64 * j]; }
#pragma unroll
            for (int rr = 0; rr < 2; ++rr) {
                float s = 0.f, mx = 0.f;
#pragma unroll
                for (int j = 0; j < 8; ++j) { s += (v[rr][j][0] * v[rr][j][0] + v[rr][j][1] * v[rr][j][1]) + (v[rr][j][2] * v[rr][j][2] + v[rr][j][3] * v[rr][j][3]);
                    mx = fmaxf(mx, fmaxf(fmaxf(fabsf(v[rr][j][0]), fabsf(v[rr][j][1])), fmaxf(fabsf(v[rr][j][2]), fabsf(v[rr][j][3])))); }
                s = wave_sum(s);
#pragma unroll
                for (int o = 1; o < 64; o <<= 1) mx = fmaxf(mx, __shfl_xor(mx, o));
                const float sc = mx > 0.f ? 127.f / mx : 0.f;
                unsigned* o4 = (unsigned*)((unsigned char*)HB + (size_t)mm[rr] * DM) + lane;
#pragma unroll
                for (int j = 0; j < 8; ++j) { unsigned w = 0u;
#pragma unroll
                    for (int e = 0; e < 4; ++e) w |= ((unsigned)(int)rintf(v[rr][j][e] * sc) & 0xffu) << (8 * e);
                    o4[64 * j] = w; }
                if (lane == 0) frow1[mm[rr]] = __builtin_amdgcn_rsqf(s * (1.f / 2048.f) + EPS) * mx * (1.f / 127.f);
            }
        }
        xcd_barrier(xbar);
        for (int it = gw; it < I_1A; it += 2 * NGW) {
            const int itB = it + NGW; float ra[32], rb[32];
            item_loads<1, true>(args.in[3], 2 * FF, args.in[2], it, lane, ra);
            if (itB < I_1A) item_loads<1, true>(args.in[3], 2 * FF, args.in[2], itB, lane, rb);
            quant_finish<1>(ra, DM, 2 * FF, (unsigned char*)W1A, colmax1, swinv1, scr, it, lane);
            if (itB < I_1A) quant_finish<1>(rb, DM, 2 * FF, (unsigned char*)W1A, colmax1, swinv1, scr, itB, lane);
        }
        __syncthreads();
    }
    SEAM(0);
    if (IN(1)) {
        pg8::Gemm g{HB, W1A, M, 2 * FF, DM / 2, DM / 2, DM / 2}; pg8::StaticOrder S; S.init(M, 2 * FF, G, bx);
        pg8::EpiSwiglu8 E{ACT, (const float*)(ws + 700416), (const float*)(ws + 650240)};
        pg8::gemm_phase(ldsl, g, S, E);
        {
            constexpr int NU = (M / 256) * (2 * FF / 256);
            const int rounds = (NU + G - 1) / G, n_full = NU - (rounds - 1) * G;
            const int nh = (n_full < G) ? G - n_full : G, hidx = (n_full < G) ? bx - n_full : bx;
            if (hidx >= 0) {
                LAS float* scr = (LAS float*)(ldsl + wave * 16384);
                constexpr int I_1B = (FF / 64) * (DM / 32), I_IN = (DM / 64) * (NIN / 32), I_A = (1024 / 64) * (DM / 32), I_O = (DM / 64) * (DM / 32);
                constexpr int NLATE = I_1B + I_IN + 2 * I_A + I_O;
                const int first = hidx * 8 + wave, stride = nh * 8;
                transpose_loop2<0, false>(args.in[4], FF, DM, W1B, nullptr, scr, first, I_1B, stride, lane);
                quant_loop2<0, true>(args.in[6], DM, NIN, (unsigned char*)WIN, args.in[5], colmax, swinv, scr, first, I_IN, stride, lane);
                transpose_loop2<0, false>(args.in[11], 1024, DM, WA, nullptr, scr, first, I_A, stride, lane);
                transpose_loop2<0, false>(args.in[12], 1024, DM, WB, nullptr, scr, first, I_A, stride, lane);
                transpose_loop2<0, false>(args.in[13], DM, DM, WOUT, nullptr, scr, first, I_O, stride, lane);
            }
            __syncthreads();
        }
    }
    SEAM(1);
    if (IN(2)) {
        pg8::Gemm g{ACT, W1B, M, DM, FF, FF, FF}; pg8::StaticOrder S; S.init(M, DM, G, bx);
        pg8::EpiResid<true, false> E{x_prompt, x_sample, out, HB, nullptr, 0.5f};
        pg8::gemm_phase(ldsl, g, S, E);
    }
    SEAM(2);
    if (IN(3)) {
        for (int m0 = gw; m0 < M; m0 += 4 * NGW) {
            u32x4 v[4][4]; int mm[4];
#pragma unroll
            for (int rr = 0; rr < 4; ++rr) { mm[rr] = (m0 + rr * NGW < M) ? m0 + rr * NGW : m0; const u32x4* row = (const u32x4*)(HB + (size_t)mm[rr] * DM);
#pragma unroll
                for (int j = 0; j < 4; ++j) v[rr][j] = row[lane + 64 * j]; }
            asm volatile("" ::: "memory");
#pragma unroll
            for (int rr = 0; rr < 4; ++rr) {
                float ss = 0.f, mx = 0.f;
#pragma unroll
                for (int j = 0; j < 4; ++j)
#pragma unroll
                    for (int e = 0; e < 4; ++e) { const float a = bf_lo(v[rr][j][e]), c = bf_hi(v[rr][j][e]); ss += a * a + c * c; mx = fmaxf(mx, fmaxf(fabsf(a), fabsf(c))); }
                ss = wave_sum(ss);
#pragma unroll
                for (int o = 1; o < 64; o <<= 1) mx = fmaxf(mx, __shfl_xor(mx, o));
                const float sc = mx > 0.f ? 127.f / mx : 0.f;
                if (rr > 0 && mm[rr] == mm[0]) continue;
                u32x2* o8 = (u32x2*)(HB + (size_t)mm[rr] * DM);
#pragma unroll
                for (int j = 0; j < 4; ++j) { unsigned w[2] = {0u, 0u};
#pragma unroll
                    for (int e = 0; e < 4; ++e) { const int q0 = (int)rintf(bf_lo(v[rr][j][e]) * sc), q1 = (int)rintf(bf_hi(v[rr][j][e]) * sc);
                        w[e >> 1] |= (((unsigned)q0 & 0xffu) | (((unsigned)q1 & 0xffu) << 8)) << (16 * (e & 1)); }
                    u32x2 o; o.x = w[0]; o.y = w[1]; o8[lane + 64 * j] = o; }
                if (lane == 0) { const float f = __builtin_amdgcn_rsqf(ss * (1.f / 2048.f) + EPS) * mx * (1.f / 127.f); frow[mm[rr]] = f;
                    ((float*)(ws + WS_RSQ))[mm[rr]] = f > 0.f ? 2048.f / (f * f) - 2048.f * EPS : 0.f; }
            }
        }
        __syncthreads();
    }
    SEAM(3);
    if (IN(4)) {
        pg8::Gemm g{HB, WIN, M, NQKV, DM / 2, DM, DM / 2}; pg8::StaticOrder S; S.init(M, NQKV, G, bx);
        pg8::EpiScaled8<0> E{QKV, NQKV, frow, swinv, nullptr};
        pg8::gemm_phase(ldsl, g, S, E);
    }
    SEAM(4);
    if (IN(5)) {
        const float* gq = args.in[8]; const float* gk = args.in[9];
        const float gq0 = gq[2 * lane], gq1 = gq[2 * lane + 1], gk0 = gk[2 * lane], gk1 = gk[2 * lane + 1];
        const float inv = __builtin_amdgcn_exp2f(-(float)(lane & 31) * (13.287712379549449f / 32.f)) * 0.15915494309189535f;
        for (int m0 = gw; m0 < M; m0 += 2 * NGW) {
            unsigned w[2][10]; unsigned* pp[2]; float sn[2], cn[2]; int mm[2];
#pragma unroll
            for (int rr = 0; rr < 2; ++rr) { mm[rr] = (m0 + rr * NGW < M) ? m0 + rr * NGW : m0;
                pp[rr] = (unsigned*)(QKV + (size_t)mm[rr] * NQKV) + lane;
#pragma unroll
                for (int hh = 0; hh < 10; ++hh) w[rr][hh] = pp[rr][64 * hh]; }
            asm volatile("" ::: "memory");
#pragma unroll
            for (int rr = 0; rr < 2; ++rr) { const int m = mm[rr]; const int t = (m < MP) ? (m & 4095) : ((m - MP) & 2047);
                const float pos = (lane < 32) ? (float)(t >> 6) : (float)(t & 63);
                const float rev = __builtin_amdgcn_fractf(pos * inv);
                sn[rr] = __builtin_amdgcn_sinf(rev); cn[rr] = __builtin_amdgcn_cosf(rev); }
#pragma unroll
            for (int rr = 0; rr < 2; ++rr) {
                if (rr == 1 && mm[1] == mm[0]) continue;
#pragma unroll
                for (int hh = 0; hh < 10; ++hh) {
                    const float x0 = bf_lo(w[rr][hh]), x1 = bf_hi(w[rr][hh]);
                    const float rn = __builtin_amdgcn_rsqf(wave_sum(x0 * x0 + x1 * x1) * (1.f / 128.f) + EPS);
                    const float y0 = x0 * rn * (hh < 8 ? gq0 : gk0), y1 = x1 * rn * (hh < 8 ? gq1 : gk1);
                    pp[rr][64 * hh] = cvt_pk_bf16(y0 * cn[rr] - y1 * sn[rr], y0 * sn[rr] + y1 * cn[rr]);
                }
            }
        }
        LAS float* scr = (LAS float*)(ldsl + wave * 16384);
        constexpr int I_1A = (DM / 64) * (2 * FF / 32), I_1B = (FF / 64) * (DM / 32);
        for (int it = gw; it < I_1A; it += 2 * NGW) {
            const int itB = it + NGW; float ra[32], rb[32];
            item_loads<1, true>(args.in[15], 2 * FF, args.in[14], it, lane, ra);
            if (itB < I_1A) item_loads<1, true>(args.in[15], 2 * FF, args.in[14], itB, lane, rb);
            transpose_finish<1>(ra, DM, 2 * FF, W1A, scr, it, lane);
            if (itB < I_1A) transpose_finish<1>(rb, DM, 2 * FF, W1A, scr, itB, lane);
        }
        transpose_loop2<0, false>(args.in[16], FF, DM, W1B, nullptr, scr, gw, I_1B, NGW, lane);
        __syncthreads();
    }
    SEAM(5);
    if (IN(6)) {
        for (int vc = bx; vc < 256; vc += G) {
            const int xcd = vc & 7, slot = vc >> 3;
#ifndef NO_DENSE
            for (int j = 0; j < 3; ++j) {
                int b, kvh, hq, qb, seq; size_t tb;
                if (j == 0) { const int combo = xcd >> 1, idx = (xcd & 1) * 32 + slot; b = combo >> 1; kvh = combo & 1; hq = kvh * 4 + (idx >> 4); qb = idx & 15; tb = (size_t)b * 4096; seq = 4096; }
                else { const int combo = xcd * 2 + j - 1; b = combo >> 1; kvh = combo & 1; hq = kvh * 4 + (slot >> 3); qb = slot & 7; tb = (size_t)MP + (size_t)b * 2048; seq = 2048; }
                __syncthreads();
                att::attn_dense_body(QKV + (tb + qb * 256) * NQKV + hq * 128, QKV + tb * NQKV + 1024 + kvh * 128, QKV + tb * NQKV + 1280 + kvh * 128,
                                     YAB + (tb + qb * 256) * DM + hq * 128, seq, (char*)lds);
            }
#endif
#ifndef NO_NA
            for (int j = 0; j < 3; ++j) {
                const int u = vc + 256 * j, h = u & 7, rb = u >> 3;
                att::na_unit(QKV, YAB, args.in[10], rb, h, (char*)lds);
            }
#endif
        }
        __syncthreads();
    }
    SEAM(6);
    if (IN(7)) {
        pg8::Gemm g{HB, WIN + (size_t)NQKV * (DM / 2), M, NGATE, DM / 2, DM, DM / 2}; pg8::StaticOrder S; S.init(M, NGATE, G, bx);
        pg8::EpiGates8 E{GT, NGATE, (const float*)(ws + WS_RSQ), args.in[7], swinv + NQKV};
        pg8::gemm_phase(ldsl, g, S, E);
    }
    SEAM(7);
    if (IN(8)) {
        pg8::Gemm g{YAB, WA, M, DM, 1024, DM, 1024}; pg8::StaticOrder S; S.init(M, DM, G, bx);
        pg8::EpiMerge<0> E{GT};
        pg8::gemm_phase(ldsl, g, S, E);
    }
    if (IN(9)) {
        pg8::Gemm g{YAB + 1024, WB, M, DM, 1024, DM, 1024}; pg8::StaticOrder S; S.init(M, DM, G, bx);
        pg8::EpiMerge<1> E{GT};
        pg8::gemm_phase(ldsl, g, S, E);
    }
    SEAM(9);
    if (IN(10)) {
        pg8::Gemm g{GT, WOUT, M, DM, DM, NGATE, DM}; pg8::StaticOrder S; S.init(M, DM, G, bx);
        pg8::EpiResid<true, true> E{out, out + (size_t)MP * DM, out, HB, ssq3, 1.0f};
        pg8::gemm_phase(ldsl, g, S, E);
    }
    SEAM(10);
    if (IN(11)) {
        pg8::Gemm g{HB, W1A, M, 2 * FF, DM, DM, DM}; pg8::StaticOrder S; S.init(M, 2 * FF, G, bx);
        pg8::EpiSwiglu E{ACT, ssq3};
        pg8::gemm_phase(ldsl, g, S, E);
    }
    SEAM(11);
    if (IN(12)) {
        pg8::Gemm g{ACT, W1B, M, DM, FF, FF, FF}; pg8::StaticOrder S; S.init(M, DM, G, bx);
        pg8::EpiResid<false, false> E{out, out + (size_t)MP * DM, out, nullptr, nullptr, 0.5f};
        pg8::gemm_phase(ldsl, g, S, E);
    }
    SEAM(12);
    if (IN(13)) {
        const f32x4* g4 = (const f32x4*)args.in[17] + lane;
        for (int m0 = gw; m0 < M; m0 += 2 * NGW) {
            f32x4 v[2][8]; float s[2] = {0.f, 0.f}; f32x4* x4[2];
#pragma unroll
            for (int rr = 0; rr < 2; ++rr) { const int m = (m0 + rr * NGW < M) ? m0 + rr * NGW : m0;
                x4[rr] = (f32x4*)(out + (size_t)m * DM) + lane;
#pragma unroll
                for (int j = 0; j < 8; ++j) v[rr][j] = x4[rr][64 * j]; }
#pragma unroll
            for (int rr = 0; rr < 2; ++rr)
#pragma unroll
                for (int j = 0; j < 8; ++j) s[rr] += (v[rr][j][0] * v[rr][j][0] + v[rr][j][1] * v[rr][j][1]) + (v[rr][j][2] * v[rr][j][2] + v[rr][j][3] * v[rr][j][3]);
#pragma unroll
            for (int rr = 0; rr < 2; ++rr) { const float rs = __builtin_amdgcn_rsqf(wave_sum(s[rr]) * (1.f / 2048.f) + EPS);
#pragma unroll
                for (int j = 0; j < 8; ++j) x4[rr][64 * j] = v[rr][j] * rs * g4[64 * j]; }
        }
    }
#undef IN
#undef SEAM
}

extern "C" void kernel_launch(void* const* d_in, const int* in_sizes, int n_in, void* d_out, int out_size, void* d_ws, size_t ws_size, hipStream_t stream) {
    static int grid = 0;
    if (grid == 0) {
        if (n_in != 18 || in_sizes[0] != MP * DM || in_sizes[1] != (M - MP) * DM || out_size != M * DM || ws_size < WS_END) {
            fprintf(stderr, "kernel_launch: shape mismatch (n_in %d, in0 %d, in1 %d, out %d, ws %zu, need ws >= %zu); nothing launched\n", n_in, n_in > 0 ? in_sizes[0] : -1, n_in > 1 ? in_sizes[1] : -1, out_size, ws_size, (size_t)WS_END);
            grid = -1; return; }
        int dev = 0, cus = 0, per_cu = 0;
        if (hipGetDevice(&dev) != hipSuccess || hipDeviceGetAttribute(&cus, hipDeviceAttributeMultiprocessorCount, dev) != hipSuccess) { grid = -1; return; }
        if (hipFuncSetAttribute((const void*)mk_fwd, hipFuncAttributeMaxDynamicSharedMemorySize, LDS_BYTES) != hipSuccess) { fprintf(stderr, "kernel_launch: hipFuncSetAttribute failed\n"); grid = -1; return; }
        if (hipOccupancyMaxActiveBlocksPerMultiprocessor(&per_cu, (const void*)mk_fwd, 512, LDS_BYTES) != hipSuccess || per_cu < 1) { fprintf(stderr, "kernel_launch: occupancy query says %d\n", per_cu); per_cu = 1; }
        (void)hipGetLastError();
        grid = cus * (per_cu > 1 ? 1 : per_cu);
    }
    if (grid < 0) return;
    static_assert(WS_SSQ2 + 2 * 98304 == WS_BAR && WS_BAR + XCD_BAR_WORDS * 4 == WS_COLMAX && WS_COLMAX + NIN * 4 == WS_COLMAX1 && WS_COLMAX1 + 2 * FF * 4 == WS_SWINV, "one contiguous zeroed region");
    (void)hipMemsetAsync((char*)d_ws + WS_SSQ2, 0, WS_SWINV - WS_SSQ2, stream);
    Args a{};
    for (int i = 0; i < 18; ++i) a.in[i] = (const float*)d_in[i];
    a.out = (float*)d_out; a.ws = (unsigned char*)d_ws;
#if MK_PER_PHASE
    for (int p = 0; p < N_PHASES; ++p) { a.ph_lo = p; a.ph_hi = p + 1; hipLaunchKernelGGL(mk_fwd, dim3(grid), dim3(512), LDS_BYTES, stream, a); }
#else
    a.ph_lo = 0; a.ph_hi = N_PHASES;
    void* kargs[] = {&a};
    hipError_t e = hipLaunchCooperativeKernel((const void*)mk_fwd, dim3(grid), dim3(512), kargs, LDS_BYTES, stream);
    if (e != hipSuccess) fprintf(stderr, "kernel_launch: cooperative launch failed: %s (grid %d)\n", hipGetErrorString(e), grid);
#endif
}
```
